# Optimizing an MI355X kernel written in HIP

```python
import jax, jax.numpy as jnp
from jax import lax
import numpy as np

D_MODEL = 1024
BATCH = 4
SEQ = 4096
DEPTH = 1

CHUNK = 64
RMS_EPS = 1e-6
ROPE_BASE = 10000.0
RET_HEADS = 4
RET_V = D_MODEL // 2
RET_QK = RET_V // 2
GLA_HEADS = 4
GLA_V = D_MODEL - RET_V
GLA_QK = GLA_V // 2
GLA_GATE_RANK = 16
GLA_GATE_NORM = 16.0
MIX_WIDTH = RET_V + GLA_V
IN_SIZES = (RET_QK, RET_QK, RET_V, RET_V, GLA_QK, GLA_QK, GLA_V, GLA_V, GLA_GATE_RANK)
IN_WIDTH = sum(IN_SIZES)
D_FF = ((8 * D_MODEL // 3 + 127) // 128) * 128

kernel_name = "macaron_retention_gla_hybrid"


def rms_norm(x, g):
    xf = x.astype(jnp.float32)
    y = xf * lax.rsqrt(jnp.mean(xf * xf, axis=-1, keepdims=True) + RMS_EPS)
    return (y * g.astype(jnp.float32)).astype(x.dtype)


def swiglu(h, w_gate, w_up, w_down):
    return (jax.nn.silu(h @ w_gate) * (h @ w_up)) @ w_down


def split_heads(t, n_heads):
    b, t_len, w = t.shape
    return t.reshape(b, t_len, n_heads, w // n_heads).transpose(0, 2, 1, 3)


def merge_heads(t):
    b, h, t_len, d = t.shape
    return t.transpose(0, 2, 1, 3).reshape(b, t_len, h * d)


def rotary(t, pos):
    dk = t.shape[-1]
    half = dk // 2
    inv = ROPE_BASE ** (-jnp.arange(half, dtype=jnp.float32) * 2.0 / dk)
    ang = pos[:, None] * inv[None, :]
    cos, sin = jnp.cos(ang), jnp.sin(ang)
    t1, t2 = t[..., :half], t[..., half:]
    return jnp.concatenate([t1 * cos - t2 * sin, t1 * sin + t2 * cos], axis=-1)


def head_rms(o):
    return o * lax.rsqrt(jnp.mean(o * o, axis=-1, keepdims=True) + RMS_EPS)


def chunk_decay_attention(q, k, v, log_a):
    bsz, n_h, t_len, dk = q.shape
    n_chunks = t_len // CHUNK
    per_key = log_a.shape[-1] != 1
    qf, kf, vf = (z.astype(jnp.float32) for z in (q, k, v))
    la = log_a.astype(jnp.float32)

    def to_chunks(z):
        return z.reshape(z.shape[0], z.shape[1], n_chunks, CHUNK, z.shape[-1]).transpose(2, 0, 1, 3, 4)

    b_cum = jnp.cumsum(to_chunks(la), axis=3)
    xs = (to_chunks(qf), to_chunks(kf), to_chunks(vf), b_cum)

    def step(state, inp):
        q_c, k_c, v_c, b_c = inp
        decay = jnp.exp(-jnp.abs(b_c[..., :, None, :] - b_c[..., None, :, :]))
        if per_key:
            scores = jnp.einsum('bhik,bhjk,bhijk->bhij', q_c, k_c, decay)
        else:
            scores = jnp.einsum('bhik,bhjk->bhij', q_c, k_c) * decay[..., 0]
        out = (jnp.einsum('bhij,bhjv->bhiv', scores, v_c)
               + jnp.einsum('bhik,bhkv->bhiv', q_c * jnp.exp(b_c), state))
        b_last = b_c[..., -1:, :]
        state = (jnp.exp(b_last[..., 0, :])[..., None] * state
                 + jnp.einsum('bhjk,bhjv->bhkv', k_c * jnp.exp(b_last - b_c), v_c))
        return state, out

    s0 = jnp.zeros((bsz, n_h, dk, v.shape[-1]), jnp.float32)
    _, outs = lax.scan(step, s0, xs)
    return outs.transpose(1, 2, 0, 3, 4).reshape(bsz, n_h, t_len, v.shape[-1])


def hybrid_mixer(h, w_in, ret_norm_g, gla_w_a2, gla_b_a, gla_norm_g, w_out):
    t_len = h.shape[1]
    pos = jnp.arange(t_len, dtype=jnp.float32)
    proj = h @ w_in
    offsets = [int(o) for o in np.cumsum(IN_SIZES)[:-1]]
    (r_q, r_k, r_v, r_g, g_q, g_k, g_v, g_g, g_low) = jnp.split(proj, offsets, axis=-1)

    rdk = RET_QK // RET_HEADS
    rq = rotary(split_heads(r_q, RET_HEADS), pos)
    rk = rotary(split_heads(r_k, RET_HEADS), pos) * (rdk ** -0.5)
    rv = split_heads(r_v, RET_HEADS)
    log_gamma = jnp.log(1.0 - 2.0 ** (-5.0 - jnp.arange(RET_HEADS, dtype=jnp.float32)))
    ret_log_a = jnp.broadcast_to(log_gamma[None, :, None, None], (1, RET_HEADS, t_len, 1))
    o_ret = head_rms(chunk_decay_attention(rq, rk, rv, ret_log_a))
    o_ret = (merge_heads(o_ret) * ret_norm_g.astype(jnp.float32)).astype(h.dtype) * jax.nn.silu(r_g)

    gdk = GLA_QK // GLA_HEADS
    gq = split_heads(g_q, GLA_HEADS) * (gdk ** -0.5)
    gk = split_heads(g_k, GLA_HEADS)
    gv = split_heads(g_v, GLA_HEADS)
    gate_logit = (g_low @ gla_w_a2 + gla_b_a).astype(jnp.float32)
    gla_log_a = split_heads(jax.nn.log_sigmoid(gate_logit) / GLA_GATE_NORM, GLA_HEADS)
    o_gla = head_rms(chunk_decay_attention(gq, gk, gv, gla_log_a))
    o_gla = (merge_heads(o_gla) * gla_norm_g.astype(jnp.float32)).astype(h.dtype) * jax.nn.silu(g_g)

    return jnp.concatenate([o_ret, o_gla], axis=-1) @ w_out


def setup_inputs(seed: int = 0) -> dict:
    key = jax.random.key(seed)
    ks = jax.random.split(key, 20)
    f32 = jnp.float32

    def nrm(k, shape, fan_in):
        return jax.random.normal(k, shape, f32) * (fan_in ** -0.5)

    def gain(k, shape):
        return 1.0 + 0.02 * jax.random.normal(k, shape, f32)

    return {
        "x": jax.random.normal(ks[0], (BATCH, SEQ, D_MODEL), f32),
        "ffn1_norm_g": gain(ks[1], (DEPTH, D_MODEL)),
        "ffn1_w_gate": nrm(ks[2], (DEPTH, D_MODEL, D_FF), D_MODEL),
        "ffn1_w_up": nrm(ks[3], (DEPTH, D_MODEL, D_FF), D_MODEL),
        "ffn1_w_down": nrm(ks[4], (DEPTH, D_FF, D_MODEL), D_FF),
        "mix_norm_g": gain(ks[5], (DEPTH, D_MODEL)),
        "w_in": nrm(ks[6], (DEPTH, D_MODEL, IN_WIDTH), D_MODEL),
        "ret_norm_g": gain(ks[7], (DEPTH, RET_V)),
        "gla_w_a2": nrm(ks[8], (DEPTH, GLA_GATE_RANK, GLA_QK), GLA_GATE_RANK),
        "gla_b_a": 0.1 * jax.random.normal(ks[9], (DEPTH, GLA_QK), f32),
        "gla_norm_g": gain(ks[10], (DEPTH, GLA_V)),
        "w_out": nrm(ks[11], (DEPTH, MIX_WIDTH, D_MODEL), MIX_WIDTH),
        "ffn2_norm_g": gain(ks[12], (DEPTH, D_MODEL)),
        "ffn2_w_gate": nrm(ks[13], (DEPTH, D_MODEL, D_FF), D_MODEL),
        "ffn2_w_up": nrm(ks[14], (DEPTH, D_MODEL, D_FF), D_MODEL),
        "ffn2_w_down": nrm(ks[15], (DEPTH, D_FF, D_MODEL), D_FF),
        "final_norm_g": gain(ks[16], (D_MODEL,)),
    }


def reference(x, ffn1_norm_g, ffn1_w_gate, ffn1_w_up, ffn1_w_down, mix_norm_g, w_in,
              ret_norm_g, gla_w_a2, gla_b_a, gla_norm_g, w_out, ffn2_norm_g,
              ffn2_w_gate, ffn2_w_up, ffn2_w_down, final_norm_g):
    for l in range(DEPTH):
        x = x + 0.5 * swiglu(rms_norm(x, ffn1_norm_g[l]), ffn1_w_gate[l], ffn1_w_up[l], ffn1_w_down[l])
        x = x + hybrid_mixer(rms_norm(x, mix_norm_g[l]), w_in[l], ret_norm_g[l], gla_w_a2[l],
                             gla_b_a[l], gla_norm_g[l], w_out[l])
        x = x + 0.5 * swiglu(rms_norm(x, ffn2_norm_g[l]), ffn2_w_gate[l], ffn2_w_up[l], ffn2_w_down[l])
    return rms_norm(x, final_norm_g)
```

```cpp
#include <hip/hip_runtime.h>
#include <cstdio>
#include <cstdint>
#include <hip/hip_cooperative_groups.h>
namespace pg8 {
#define PG8_LAS __attribute__((address_space(3)))
typedef unsigned short bf16_t;
typedef short bf16x8 __attribute__((ext_vector_type(8)));
typedef float f32x4 __attribute__((ext_vector_type(4)));
typedef unsigned u32x4 __attribute__((ext_vector_type(4)));
constexpr int BM = 256, BK = 64, HALF = 128, HTB = HALF * BK * 2  , STAGE_BYTES = 8 * HTB, NXCD = 8, WGM = 8;

__host__ __device__ __forceinline__ int lds_byte(int r, int c) { const int st = (r >> 4) * 2 + (c >> 5), rr = r & 15, cc = c & 31, ob = rr * 64 + cc * 2; return st * 1024 + (ob ^ (((ob >> 9) & 1) << 5)); }
__host__ __device__ __forceinline__ void stage_rc(int b, int& R, int& C) { const int st = b / 1024, sb = b % 1024, swz = sb ^ (((sb >> 9) & 1) << 5); R = (st >> 1) * 16 + swz / 64; C = (st & 1) * 32 + (swz % 64) / 2; }
__host__ __device__ __forceinline__ int perm32(int rho) { const int n = rho >> 4, i = rho & 15; return 8 * (i >> 2) + 4 * n + (i & 3); }

struct Unit { int pm, pn; };
struct Gemm { const bf16_t* A; const bf16_t* Bt; int M, N, K; };

struct StaticOrder {
    int nM, nN, nwg, G, c;
    __host__ __device__ void init(int M, int N, int G_, int c_) { nM = M / BM; nN = N / BM; nwg = nM * nN; G = G_; c = c_; }
    __host__ __device__ bool next(int i, Unit& u) const {
        const long L = (long)i * G + c; if (L >= nwg) return false;
        int wgid = (int)L; { const int q = nwg / NXCD, r = nwg % NXCD, xcd = wgid % NXCD, off = wgid / NXCD; wgid = (xcd < r ? xcd * (q + 1) : r * (q + 1) + (xcd - r) * q) + off; }
        const int nig = WGM * nN, gid = wgid / nig, fm = gid * WGM, gsz = (nM - fm) < WGM ? (nM - fm) : WGM;
        u.pm = fm + ((wgid % nig) % gsz); u.pn = (wgid % nig) / gsz; return true;
    }
    __device__ __forceinline__ void a_ready(const Unit&) const {}
    __device__ __forceinline__ void done(const Unit&) const {}
};

__device__ __forceinline__ unsigned cvt_pk_bf16(float lo, float hi) { unsigned r; asm volatile("v_cvt_pk_bf16_f32 %0, %1, %2" : "=v"(r) : "v"(lo), "v"(hi)); return r; }
typedef float f32x2 __attribute__((ext_vector_type(2)));
__device__ __forceinline__ f32x2 gelu_pk(f32x2 v) {
    const f32x2 av = __builtin_elementwise_abs(v), d = av * 0.2316418882f + 1.0f;
    f32x2 t; t.x = __builtin_amdgcn_rcpf(d.x); t.y = __builtin_amdgcn_rcpf(d.y);
    f32x2 q = t * 0.5307027145f + (-0.7265760135f); q = q * t + 0.7107068705f; q = q * t + (-0.142248368f); q = q * t + 0.127414796f; q = q * t;
    const f32x2 s = (v * v) * (-0.72134752044f);
    f32x2 e; e.x = __builtin_amdgcn_exp2f(s.x); e.y = __builtin_amdgcn_exp2f(s.y);
    const f32x2 m = v * (q * e), r = v - m;
    f32x2 o; o.x = v.x < 0.f ? m.x : r.x; o.y = v.y < 0.f ? m.y : r.y; return o;
}

template <int ACT  > struct EpiBf16 {
    static constexpr bool PERM = true, AFTER_DRAIN = false; static_assert(ACT == 0 || ACT == 1, "EpiBf16: ACT is 0 (none) or 1 (gelu_pk)");
    bf16_t* O; int ldc; const float* bias; int split_cols; size_t split_stride; float scale0;
    __device__ __forceinline__ void operator()(const f32x4 (&acc)[2][2][4][2], const Unit& u, int wr, int wc, int fr, int fq) const {
        const int row0 = u.pm * BM + wr * 64 + fr; int colt = u.pn * BM; bf16_t* base = O;
        float sc = 1.f; if (split_cols) { const int t = colt / split_cols; base += (size_t)t * split_stride; colt -= t * split_cols; if (t == 0) sc = scale0; }
        const int col0 = colt + wc * 32 + 8 * fq, bcol0 = u.pn * BM + wc * 32 + 8 * fq;
        f32x4 bv[2][2];
#pragma unroll
        for (int bj = 0; bj < 2; ++bj)
#pragma unroll
            for (int n = 0; n < 2; ++n) bv[bj][n] = bias ? *(const f32x4*)(bias + bcol0 + bj * HALF + 4 * n) : (f32x4){0.f, 0.f, 0.f, 0.f};
#pragma unroll
        for (int ai = 0; ai < 2; ++ai)
#pragma unroll
            for (int m = 0; m < 4; ++m) { bf16_t* rowp = base + (size_t)(row0 + ai * HALF + m * 16) * ldc + col0;
#pragma unroll
                for (int bj = 0; bj < 2; ++bj) { f32x4 v0 = acc[ai][bj][m][0] + bv[bj][0], v1 = acc[ai][bj][m][1] + bv[bj][1];
                    if (ACT == 1) { f32x2 a = gelu_pk((f32x2){v0[0], v0[1]}), b = gelu_pk((f32x2){v0[2], v0[3]}), c = gelu_pk((f32x2){v1[0], v1[1]}), d = gelu_pk((f32x2){v1[2], v1[3]});
                        v0 = (f32x4){a.x, a.y, b.x, b.y}; v1 = (f32x4){c.x, c.y, d.x, d.y}; }
                    v0 = v0 * sc; v1 = v1 * sc; u32x4 w; w.x = cvt_pk_bf16(v0[0], v0[1]); w.y = cvt_pk_bf16(v0[2], v0[3]); w.z = cvt_pk_bf16(v1[0], v1[1]); w.w = cvt_pk_bf16(v1[2], v1[3]);
                    *(u32x4*)(rowp + bj * HALF) = w; } }
    }
};
template <class Epi, class Sched, bool ALIGN_EPI = false, bool SP2 = false>
__device__ __forceinline__ void gemm_phase(PG8_LAS unsigned char* lds, const Gemm g, const Sched& S, const Epi& E) {
    const int tid = threadIdx.x, wid = __builtin_amdgcn_readfirstlane(tid >> 6), lane = tid & 63, wr = wid >> 2, wc = wid & 3, fr = lane & 15, fq = lane >> 4;
    const int K = g.K, nt = K / BK;
    unsigned voffA[2], voffB[2];
#pragma unroll
    for (int i = 0; i < 2; ++i) { int R, C; stage_rc(tid * 16 + i * 8192, R, C); const int Rb = Epi::PERM ? ((R & ~31) + perm32(R & 31)) : R;
        voffA[i] = (unsigned)(R * K + C) * 2u; voffB[i] = (unsigned)(Rb * K + C) * 2u; }
    const size_t kstep = (size_t)(BK * 2);
    const size_t hstep = (size_t)HALF * K * 2;
    const size_t tstep = 2 * hstep;
    const unsigned ldsw = (unsigned)wid * 1024u;
    const int aoff = lds_byte(wr * 64 + fr, fq * 8), boff = lds_byte(wc * 32 + fr, fq * 8);
#define PG8_SA(b, h) (((b) * 2 + (h)) * HTB)
#define PG8_SB(b, h) ((4 + (b) * 2 + (h)) * HTB)
#define PG8_STAGE(bufoff, gbase, voff) do { _Pragma("unroll") for (int _i = 0; _i < 2; ++_i) \
        __builtin_amdgcn_global_load_lds((const unsigned*)((const char*)(gbase) + (voff)[_i]), (PG8_LAS unsigned*)(lds + (bufoff) + ldsw + _i * 8192), 16, 0, 0); } while (0)
#define PG8_LDA(dst, b, h) do { _Pragma("unroll") for (int m = 0; m < 4; ++m) _Pragma("unroll") for (int k = 0; k < 2; ++k) dst[m][k] = *(const PG8_LAS bf16x8*)(lds + PG8_SA(b, h) + aoff + m * 2048 + k * 1024); } while (0)
#define PG8_LDB(dst, b, h) do { _Pragma("unroll") for (int n = 0; n < 2; ++n) _Pragma("unroll") for (int k = 0; k < 2; ++k) dst[n][k] = *(const PG8_LAS bf16x8*)(lds + PG8_SB(b, h) + boff + n * 2048 + k * 1024); } while (0)
#define PG8_MMA(ai, bj, At, Bt) do { __builtin_amdgcn_s_setprio(1); _Pragma("unroll") for (int m = 0; m < 4; ++m) _Pragma("unroll") for (int n = 0; n < 2; ++n) _Pragma("unroll") for (int k = 0; k < 2; ++k) \
        acc[ai][bj][m][n] = __builtin_amdgcn_mfma_f32_16x16x32_bf16(Bt[n][k], At[m][k], acc[ai][bj][m][n], 0, 0, 0); __builtin_amdgcn_s_setprio(0); } while (0)
#define PG8_WAIT_V(n) asm volatile("s_waitcnt vmcnt(" #n ")" ::: "memory")
#define PG8_WAIT_L(n) asm volatile("s_waitcnt lgkmcnt(" #n ")" ::: "memory")
#define PG8_BAR __builtin_amdgcn_s_barrier()
#define PG8_SCHED __builtin_amdgcn_sched_barrier(0)
    Unit cur, nxt; int ui = 0;
    if (!S.next(0, cur)) return;
    f32x4 acc[2][2][4][2];
#pragma unroll
    for (int a = 0; a < 2; ++a)
#pragma unroll
        for (int b = 0; b < 2; ++b)
#pragma unroll
            for (int m = 0; m < 4; ++m)
#pragma unroll
                for (int n = 0; n < 2; ++n) acc[a][b][m][n] = (f32x4){0.f, 0.f, 0.f, 0.f};
    bf16x8 At[4][2], B0[2][2], B1[2][2];
    const char* cA = (const char*)g.A + (size_t)cur.pm * tstep; const char* cB = (const char*)g.Bt + (size_t)cur.pn * tstep;
    S.a_ready(cur);
    if constexpr (SP2) {
        PG8_STAGE(PG8_SB(0, 0), cB, voffB); PG8_STAGE(PG8_SB(0, 1), cB + hstep, voffB); PG8_STAGE(PG8_SA(0, 0), cA, voffA); PG8_STAGE(PG8_SA(0, 1), cA + hstep, voffA);
        if (wr == 1) PG8_BAR;
        PG8_WAIT_V(2); PG8_BAR;
        PG8_STAGE(PG8_SB(1, 0), cB + kstep, voffB); PG8_STAGE(PG8_SA(1, 0), cA + kstep, voffA); PG8_STAGE(PG8_SB(1, 1), cB + hstep + kstep, voffB);
        PG8_WAIT_V(6); PG8_BAR;
    } else {
        PG8_STAGE(PG8_SB(0, 0), cB, voffB); PG8_STAGE(PG8_SA(0, 0), cA, voffA); PG8_STAGE(PG8_SB(0, 1), cB + hstep, voffB); PG8_STAGE(PG8_SA(0, 1), cA + hstep, voffA);
        if (wr == 1) PG8_BAR;
        PG8_WAIT_V(4); PG8_BAR;
        PG8_STAGE(PG8_SB(1, 0), cB + kstep, voffB); PG8_STAGE(PG8_SA(1, 0), cA + kstep, voffA); PG8_STAGE(PG8_SB(1, 1), cB + hstep + kstep, voffB);
        PG8_WAIT_V(6); PG8_BAR;
    }
    for (;;) {
        const bool has_next = S.next(ui + 1, nxt);
        const char* nA = has_next ? (const char*)g.A + (size_t)nxt.pm * tstep : cA; const char* nB = has_next ? (const char*)g.Bt + (size_t)nxt.pn * tstep : cB;
        for (int t = 0; t < nt; t += 2) {
            const bool last = (t == nt - 2);
            const char* a1 = cA + (size_t)(t + 1) * kstep;
            const char* a2 = last ? nA : cA + (size_t)(t + 2) * kstep; const char* b2 = last ? nB : cB + (size_t)(t + 2) * kstep;
            const char* a3 = a2 + kstep; const char* b3 = b2 + kstep;
            if (last && has_next) S.a_ready(nxt);
            if constexpr (SP2) {
            PG8_LDB(B0, 0, 0); PG8_LDB(B1, 0, 1); PG8_SCHED; PG8_LDA(At, 0, 0); PG8_STAGE(PG8_SA(1, 1), a1 + hstep, voffA);
            PG8_WAIT_V(8); PG8_WAIT_L(0); PG8_BAR; PG8_MMA(0, 0, At, B0); PG8_MMA(0, 1, At, B1); PG8_BAR; PG8_SCHED;
            PG8_LDA(At, 0, 1); PG8_STAGE(PG8_SB(0, 0), b2, voffB); PG8_STAGE(PG8_SB(0, 1), b2 + hstep, voffB); PG8_STAGE(PG8_SA(0, 0), a2, voffA);
            PG8_WAIT_V(8); PG8_WAIT_L(0); PG8_BAR; PG8_MMA(1, 0, At, B0); PG8_MMA(1, 1, At, B1); PG8_BAR; PG8_SCHED;
            PG8_LDB(B0, 1, 0); PG8_LDB(B1, 1, 1); PG8_SCHED; PG8_LDA(At, 1, 0); PG8_STAGE(PG8_SA(0, 1), a2 + hstep, voffA);
            PG8_WAIT_V(8); PG8_WAIT_L(0); PG8_BAR; PG8_MMA(0, 0, At, B0); PG8_MMA(0, 1, At, B1); PG8_BAR; PG8_SCHED;
            PG8_LDA(At, 1, 1); PG8_STAGE(PG8_SB(1, 0), b3, voffB); PG8_STAGE(PG8_SB(1, 1), b3 + hstep, voffB); PG8_STAGE(PG8_SA(1, 0), a3, voffA);
            PG8_WAIT_V(8); PG8_WAIT_L(0); PG8_BAR; PG8_MMA(1, 0, At, B0); PG8_MMA(1, 1, At, B1); PG8_BAR; PG8_SCHED;
            } else {
            PG8_LDB(B0, 0, 0); PG8_SCHED; PG8_LDA(At, 0, 0); PG8_STAGE(PG8_SA(1, 1), a1 + hstep, voffA);
            PG8_WAIT_L(8); PG8_BAR; PG8_WAIT_L(0); PG8_MMA(0, 0, At, B0); PG8_BAR; PG8_SCHED;
            PG8_LDB(B1, 0, 1); PG8_STAGE(PG8_SB(0, 0), b2, voffB);
            PG8_BAR; PG8_WAIT_L(0); PG8_MMA(0, 1, At, B1); PG8_BAR;
            PG8_LDA(At, 0, 1); PG8_STAGE(PG8_SA(0, 0), a2, voffA);
            PG8_BAR; PG8_WAIT_L(0); PG8_MMA(1, 0, At, B0); PG8_BAR; PG8_SCHED;
            PG8_STAGE(PG8_SB(0, 1), b2 + hstep, voffB);
            PG8_WAIT_V(6); PG8_BAR; PG8_MMA(1, 1, At, B1); PG8_BAR;
            PG8_LDB(B0, 1, 0); PG8_SCHED; PG8_LDA(At, 1, 0); PG8_STAGE(PG8_SA(0, 1), a2 + hstep, voffA);
            PG8_WAIT_L(8); PG8_BAR; PG8_WAIT_L(0); PG8_MMA(0, 0, At, B0); PG8_BAR; PG8_SCHED;
            PG8_LDB(B1, 1, 1); PG8_STAGE(PG8_SB(1, 0), b3, voffB);
            PG8_BAR; PG8_WAIT_L(0); PG8_MMA(0, 1, At, B1); PG8_BAR;
            PG8_LDA(At, 1, 1); PG8_STAGE(PG8_SA(1, 0), a3, voffA);
            PG8_BAR; PG8_WAIT_L(0); PG8_MMA(1, 0, At, B0); PG8_BAR; PG8_SCHED;
            PG8_STAGE(PG8_SB(1, 1), b3 + hstep, voffB);
            PG8_WAIT_V(6); PG8_BAR; PG8_MMA(1, 1, At, B1); PG8_BAR;
            }
        }
        if constexpr (ALIGN_EPI) { if (wr == 0) PG8_BAR; }
        if constexpr (!Epi::AFTER_DRAIN) { E(acc, cur, wr, wc, fr, fq); S.done(cur); }
        if (!has_next) break;
#pragma unroll
        for (int a = 0; a < 2; ++a)
#pragma unroll
            for (int b = 0; b < 2; ++b)
#pragma unroll
                for (int m = 0; m < 4; ++m)
#pragma unroll
                    for (int n = 0; n < 2; ++n) acc[a][b][m][n] = (f32x4){0.f, 0.f, 0.f, 0.f};
        cur = nxt; cA = nA; cB = nB; ++ui;
        if constexpr (ALIGN_EPI) { if (wr == 1) PG8_BAR; }
    }
    PG8_WAIT_V(0);
    if constexpr (!ALIGN_EPI) { if (wr == 0) PG8_BAR; }
    PG8_BAR;
    if constexpr (Epi::AFTER_DRAIN) { E.fused(acc, cur, wr, wc, fr, fq, lds, wid, lane); S.done(cur); }
#undef PG8_SA
#undef PG8_SB
#undef PG8_STAGE
#undef PG8_LDA
#undef PG8_LDB
#undef PG8_MMA
#undef PG8_WAIT_V
#undef PG8_WAIT_L
#undef PG8_BAR
#undef PG8_SCHED
}
}

#ifndef PG8_SP2
#define PG8_SP2 true
#endif
#ifndef PG8_ALIGN
#define PG8_ALIGN true
#endif
namespace cg = cooperative_groups;
#define GAS __attribute__((address_space(1)))
#define LAS __attribute__((address_space(3)))
typedef unsigned short bf16;
typedef unsigned v4u __attribute__((ext_vector_type(4)));
typedef unsigned v2u __attribute__((ext_vector_type(2)));
typedef float f32x4 __attribute__((ext_vector_type(4)));
typedef float f32x2v __attribute__((ext_vector_type(2)));
typedef short bf16x8 __attribute__((ext_vector_type(8)));

constexpr int NWAVES = 8, NTHR = 512;
constexpr int BATCH = 4, T = 4096, D = 1024, M = BATCH * T, FF = 2816, NGU = 2 * FF, INW = 3088, LDP = 3328, CH = 64, NCH = T / CH;
constexpr int NUNITS = BATCH * 8 * NCH;
constexpr float RMS_EPS = 1e-6f;
constexpr size_t MiB = 1u << 20;
constexpr size_t WS_WGU1 = 0, WS_WD1 = 11 * MiB, WS_WIN = 33 * MiB / 2, WS_WOUT = 23 * MiB, WS_WGU2 = 25 * MiB, WS_WD2 = 36 * MiB;
constexpr size_t WS_TAB = 42 * MiB, WS_DEC = 43 * MiB, WS_H = 46 * MiB, WS_ST = WS_H, WS_PROJ = 78 * MiB, WS_ACT = WS_PROJ, WS_KV = 182 * MiB, WS_O = WS_KV, WS_END = 246 * MiB;
static_assert(WS_WD1 + (size_t)D * FF * 2 <= WS_WIN && WS_WIN + (size_t)LDP * D * 2 <= WS_WOUT && WS_WD2 + (size_t)D * FF * 2 <= WS_TAB, "ws map");
static_assert(WS_PROJ + (size_t)M * LDP * 2 <= WS_KV && WS_KV + (size_t)NUNITS * 8192 * 4 <= WS_END, "ws map");
constexpr int LDS_BYTES = 147456;
constexpr int PB = 144;
constexpr int L_QP = 0, L_QM = 9216, L_KP = 18432, L_KM = 27648, L_QE = 36864, L_VT = 46080, L_PS = 64512, L_BS = 73728, L_LOW = 90368, L_TOT = 94464, L_RED = 96512, L_KDT = 0;

__device__ __forceinline__ unsigned pk2(float lo, float hi) { return pg8::cvt_pk_bf16(lo, hi); }
__device__ __forceinline__ float bf2f(unsigned h) { return __builtin_bit_cast(float, h << 16); }
__device__ __forceinline__ float bflo(unsigned w) { return __builtin_bit_cast(float, w << 16); }
__device__ __forceinline__ float bfhi(unsigned w) { return __builtin_bit_cast(float, w & 0xffff0000u); }
__device__ __forceinline__ float wave_sum(float v) {
#pragma unroll
    for (int o = 1; o < 64; o <<= 1) v += __shfl_xor(v, o);
    return v;
}
__device__ __forceinline__ float silu_f(float g) { return g * __builtin_amdgcn_rcpf(1.0f + __expf(-g)); }

struct EpiSwiGLU {
    static constexpr bool PERM = true, AFTER_DRAIN = false;
    bf16* O; int ldc;
    __device__ __forceinline__ void operator()(const pg8::f32x4 (&acc)[2][2][4][2], const pg8::Unit& u, int wr, int wc, int fr, int fq) const {
        const int row0 = u.pm * 256 + wr * 64 + fr, col0 = u.pn * 128 + wc * 32 + 8 * fq;
#pragma unroll
        for (int ai = 0; ai < 2; ++ai)
#pragma unroll
            for (int m = 0; m < 4; ++m) {
                bf16* rowp = O + (size_t)(row0 + ai * 128 + m * 16) * ldc + col0;
                const pg8::f32x4 g0 = acc[ai][0][m][0], g1 = acc[ai][0][m][1], u0 = acc[ai][1][m][0], u1 = acc[ai][1][m][1];
                v4u w;
                w.x = pk2(silu_f(g0[0]) * u0[0], silu_f(g0[1]) * u0[1]); w.y = pk2(silu_f(g0[2]) * u0[2], silu_f(g0[3]) * u0[3]);
                w.z = pk2(silu_f(g1[0]) * u1[0], silu_f(g1[1]) * u1[1]); w.w = pk2(silu_f(g1[2]) * u1[2], silu_f(g1[3]) * u1[3]);
                *(v4u*)rowp = w;
            }
    }
};
struct EpiResid {
    static constexpr bool PERM = false, AFTER_DRAIN = false;
    const float* base; float* out; int ldc; float scale;
    __device__ __forceinline__ void operator()(const pg8::f32x4 (&acc)[2][2][4][2], const pg8::Unit& u, int wr, int wc, int fr, int fq) const {
        const int col0 = u.pn * 256 + wc * 32 + 4 * fq;
#pragma unroll
        for (int ai = 0; ai < 2; ++ai)
#pragma unroll
            for (int m = 0; m < 4; ++m) {
                const size_t off = (size_t)(u.pm * 256 + ai * 128 + wr * 64 + m * 16 + fr) * ldc + col0;
#pragma unroll
                for (int bj = 0; bj < 2; ++bj)
#pragma unroll
                    for (int n = 0; n < 2; ++n) {
                        const pg8::f32x4 bs = *(const pg8::f32x4*)(base + off + bj * 128 + n * 16);
                        *(pg8::f32x4*)(out + off + bj * 128 + n * 16) = bs + acc[ai][bj][m][n] * scale;
                    }
                asm volatile("" ::: "memory");
            }
    }
};

__device__ __forceinline__ void transpose_item(const float* W, int K, int N, bf16* WT, int nblk, int mode, LAS float* scr, int item, int lane) {
    const int kb = item / nblk, nb = item % nblk, k0 = 64 * kb, n0 = 32 * nb;
    const int nn = n0 + (lane & 31); const bool ok = nn < N;
#pragma unroll 8
    for (int i = 0; i < 32; ++i) { const int kk = 2 * i + (lane >> 5); scr[kk * 33 + (lane & 31)] = ok ? W[(size_t)(k0 + kk) * N + nn] : 0.f; }
    asm volatile("s_waitcnt lgkmcnt(0)" ::: "memory");
    const int c = lane & 7;
    const int drow0 = mode == 0 ? n0 : (256 * (n0 >> 7) + (n0 & 127) + (mode == 2 ? 128 : 0));
#pragma unroll
    for (int j = 0; j < 4; ++j) { const int n = (lane >> 3) + 8 * j; const LAS float* s = scr + (8 * c) * 33 + n;
        v4u o; o.x = pk2(s[0 * 33], s[1 * 33]); o.y = pk2(s[2 * 33], s[3 * 33]); o.z = pk2(s[4 * 33], s[5 * 33]); o.w = pk2(s[6 * 33], s[7 * 33]);
        *(v4u*)(WT + (size_t)(drow0 + n) * K + k0 + 8 * c) = o; }
    asm volatile("s_waitcnt lgkmcnt(0)" ::: "memory");
}
__device__ __forceinline__ void norm_row_bf16(const float* xrow, const float* g, bf16* orow, int lane) {
    const f32x4* xr = (const f32x4*)xrow + lane; const f32x4* gr = (const f32x4*)g + lane;
    f32x4 v[4]; float s = 0.f;
#pragma unroll
    for (int j = 0; j < 4; ++j) { v[j] = xr[64 * j]; s += (v[j].x * v[j].x + v[j].y * v[j].y) + (v[j].z * v[j].z + v[j].w * v[j].w); }
    const float r = 1.0f / sqrtf(wave_sum(s) * (1.f / D) + RMS_EPS);
    v2u* o8 = (v2u*)orow + lane;
#pragma unroll
    for (int j = 0; j < 4; ++j) { const f32x4 gg = gr[64 * j]; v2u o; o.x = pk2(v[j].x * r * gg.x, v[j].y * r * gg.y); o.y = pk2(v[j].z * r * gg.z, v[j].w * r * gg.w); o8[64 * j] = o; }
}
__device__ __forceinline__ void norm_row_f32(float* xrow, const float* g, int lane) {
    f32x4* xr = (f32x4*)xrow + lane; const f32x4* gr = (const f32x4*)g + lane;
    f32x4 v[4]; float s = 0.f;
#pragma unroll
    for (int j = 0; j < 4; ++j) { v[j] = xr[64 * j]; s += (v[j].x * v[j].x + v[j].y * v[j].y) + (v[j].z * v[j].z + v[j].w * v[j].w); }
    const float r = 1.0f / sqrtf(wave_sum(s) * (1.f / D) + RMS_EPS);
#pragma unroll
    for (int j = 0; j < 4; ++j) { const f32x4 gg = gr[64 * j]; xr[64 * j] = (f32x4){v[j].x * r * gg.x, v[j].y * r * gg.y, v[j].z * r * gg.z, v[j].w * r * gg.w}; }
}

struct UnitInfo { int b, h8, n, h; bool gla; size_t m0; int qcol, kcol, vcol, gcol, ocol; };
__device__ __forceinline__ UnitInfo unit_info(int u) {
    UnitInfo I; I.n = u & 63; I.h8 = (u >> 6) & 7; I.b = u >> 9; I.gla = I.h8 >= 4; I.h = I.h8 & 3; I.m0 = (size_t)I.b * T + (size_t)I.n * CH;
    const int base = I.gla ? 1536 : 0;
    I.qcol = base + 64 * I.h; I.kcol = base + 256 + 64 * I.h; I.vcol = base + 512 + 128 * I.h; I.gcol = base + 1024 + 128 * I.h; I.ocol = (I.gla ? 512 : 0) + 128 * I.h;
    return I;
}
__device__ __forceinline__ void attn_compute_b(LAS unsigned char* lds, const UnitInfo& I, const bf16* proj, const float* w_a2, const float* b_a, int tid) {
    LAS float* BS = (LAS float*)(lds + L_BS); LAS float* LOW = (LAS float*)(lds + L_LOW); LAS float* TOT = (LAS float*)(lds + L_TOT);
    const int k = tid & 63, w = tid >> 6;
    if (I.gla) {
        { const int j = tid >> 3, r = (tid & 7) * 2; const unsigned v = *(const unsigned*)(proj + (I.m0 + j) * LDP + 3072 + r); LOW[j * 16 + r] = bflo(v); LOW[j * 16 + r + 1] = bfhi(v); }
        float wa[16];
#pragma unroll
        for (int r = 0; r < 16; ++r) wa[r] = w_a2[r * 256 + 64 * I.h + k];
        const float ba = b_a[64 * I.h + k];
        __syncthreads();
        float la[8]; float run = 0.f;
#pragma unroll
        for (int jj = 0; jj < 8; ++jj) {
            const LAS f32x4* lp = (const LAS f32x4*)(LOW + (8 * w + jj) * 16);
            float z = ba;
#pragma unroll
            for (int q = 0; q < 4; ++q) { const f32x4 l4 = lp[q]; z += l4.x * wa[4 * q] + l4.y * wa[4 * q + 1] + l4.z * wa[4 * q + 2] + l4.w * wa[4 * q + 3]; }
            const float ls = fminf(z, 0.f) - __logf(1.0f + __expf(-fabsf(z)));
            run += ls * 0.0625f; la[jj] = run;
        }
        TOT[w * 64 + k] = run;
        __syncthreads();
        float off = 0.f;
#pragma unroll
        for (int w2 = 0; w2 < 7; ++w2) off += (w2 < w) ? TOT[w2 * 64 + k] : 0.f;
#pragma unroll
        for (int jj = 0; jj < 8; ++jj) BS[(8 * w + jj) * 65 + k] = la[jj] + off;
    } else {
        const float lg = __logf(1.0f - exp2f(-5.0f - (float)I.h));
#pragma unroll
        for (int jj = 0; jj < 8; ++jj) BS[(8 * w + jj) * 65 + k] = (float)(8 * w + jj + 1) * lg;
    }
    __syncthreads();
}
__device__ __forceinline__ void load_qk8(const bf16* p, float (&lo)[4], float (&hi)[4]) {
    const v2u x = *(const v2u*)p, y = *(const v2u*)(p + 32);
    lo[0] = bflo(x.x); lo[1] = bfhi(x.x); lo[2] = bflo(x.y); lo[3] = bfhi(x.y);
    hi[0] = bflo(y.x); hi[1] = bfhi(y.x); hi[2] = bflo(y.y); hi[3] = bfhi(y.y);
}
__device__ __forceinline__ void rotary8(const float* tabp, float (&lo)[4], float (&hi)[4]) {
    const f32x4 t0 = ((const f32x4*)tabp)[0], t1 = ((const f32x4*)tabp)[1];
    const float c[4] = {t0.x, t0.z, t1.x, t1.z}, s[4] = {t0.y, t0.w, t1.y, t1.w};
#pragma unroll
    for (int e = 0; e < 4; ++e) { const float a = lo[e], b = hi[e]; lo[e] = a * c[e] - b * s[e]; hi[e] = a * s[e] + b * c[e]; }
}
__device__ __forceinline__ int swz_off(int row, int col) { return row * PB + ((((col >> 3) ^ (row >> 3)) & 7) << 4) + (col & 7) * 2; }
__device__ __forceinline__ void stage_vt(LAS unsigned char* lds, const UnitInfo& I, const bf16* proj, int tid) {
    const int c = tid & 15;
#pragma unroll
    for (int p = 0; p < 2; ++p) {
        const int j = (tid >> 4) + 32 * p;
        const v4u x = *(const v4u*)(proj + (I.m0 + j) * LDP + I.vcol + 8 * c);
        const unsigned xs[4] = {x.x, x.y, x.z, x.w};
#pragma unroll
        for (int e = 0; e < 8; ++e) { const unsigned short val = (unsigned short)((xs[e >> 1] >> (16 * (e & 1))) & 0xffffu);
            *(LAS unsigned short*)(lds + L_VT + swz_off(8 * c + e, j)) = val; }
    }
}
__device__ __forceinline__ bf16x8 frag_plain(LAS unsigned char* base, int t16, int kk, int lane) { const int row = 16 * t16 + (lane & 15); return *(const LAS bf16x8*)(base + row * PB + (32 * kk + 8 * (lane >> 4)) * 2); }
__device__ __forceinline__ bf16x8 frag_swz(LAS unsigned char* base, int t16, int kk, int lane) { const int row = 16 * t16 + (lane & 15); const int jc = 4 * kk + (lane >> 4); return *(const LAS bf16x8*)(base + row * PB + (((jc ^ (row >> 3)) & 7) << 4)); }
#define MFMA16(X, Y, C) __builtin_amdgcn_mfma_f32_16x16x32_bf16((X), (Y), (C), 0, 0, 0)

__device__ __forceinline__ void attn_pass_a(LAS unsigned char* lds, int u, const bf16* proj, const float* tab, const float* w_a2, const float* b_a, float* KV, float* DEC, int tid) {
    const UnitInfo I = unit_info(u); const int lane = tid & 63, w = tid >> 6;
    LAS float* BS = (LAS float*)(lds + L_BS);
    attn_compute_b(lds, I, proj, w_a2, b_a, tid);
    {
        const int j = tid >> 3, g = tid & 7;
        float klo[4], khi[4];
        load_qk8(proj + (I.m0 + j) * LDP + I.kcol + 4 * g, klo, khi);
        if (!I.gla) { rotary8(tab + ((size_t)(I.n * CH + j) * 32 + 4 * g) * 2, klo, khi);
#pragma unroll
            for (int e = 0; e < 4; ++e) { klo[e] *= 0.125f; khi[e] *= 0.125f; } }
#pragma unroll
        for (int e = 0; e < 4; ++e) {
            const int c0 = 4 * g + e, c1 = c0 + 32;
            const float d0 = __expf(BS[63 * 65 + c0] - BS[j * 65 + c0]), d1 = __expf(BS[63 * 65 + c1] - BS[j * 65 + c1]);
            *(LAS unsigned short*)(lds + L_KDT + swz_off(c0, j)) = (unsigned short)(pk2(klo[e] * d0, 0.f) & 0xffffu);
            *(LAS unsigned short*)(lds + L_KDT + swz_off(c1, j)) = (unsigned short)(pk2(khi[e] * d1, 0.f) & 0xffffu);
        }
        if (tid < 64) DEC[(size_t)u * 64 + tid] = __expf(BS[63 * 65 + tid]);
    }
    stage_vt(lds, I, proj, tid);
    __syncthreads();
    {
        const int vt = w; float* KVu = KV + (size_t)u * 8192;
#pragma unroll
        for (int kt = 0; kt < 4; ++kt) {
            f32x4 acc = {0.f, 0.f, 0.f, 0.f};
#pragma unroll
            for (int kk = 0; kk < 2; ++kk) acc = MFMA16(frag_swz(lds + L_VT, vt, kk, lane), frag_swz(lds + L_KDT, kt, kk, lane), acc);
            const int v0 = 16 * vt + 4 * (lane >> 4), k = 16 * kt + (lane & 15);
#pragma unroll
            for (int e = 0; e < 4; ++e) KVu[(v0 + e) * 64 + k] = acc[e];
        }
    }
}
__device__ __forceinline__ void attn_pass_c(LAS unsigned char* lds, int u, const bf16* proj, const float* tab, const float* w_a2, const float* b_a, const bf16* ST, const float* ng_ret, const float* ng_gla, bf16* O, int tid) {
    const UnitInfo I = unit_info(u); const int lane = tid & 63, w = tid >> 6;
    LAS float* BS = (LAS float*)(lds + L_BS); LAS float* RED = (LAS float*)(lds + L_RED);
    attn_compute_b(lds, I, proj, w_a2, b_a, tid);
    {
        const int j = tid >> 3, g = tid & 7;
        float qlo[4], qhi[4], klo[4], khi[4];
        load_qk8(proj + (I.m0 + j) * LDP + I.qcol + 4 * g, qlo, qhi);
        load_qk8(proj + (I.m0 + j) * LDP + I.kcol + 4 * g, klo, khi);
        if (!I.gla) { const float* tp = tab + ((size_t)(I.n * CH + j) * 32 + 4 * g) * 2; rotary8(tp, qlo, qhi); rotary8(tp, klo, khi);
#pragma unroll
            for (int e = 0; e < 4; ++e) { klo[e] *= 0.125f; khi[e] *= 0.125f; } }
        else {
#pragma unroll
            for (int e = 0; e < 4; ++e) { qlo[e] *= 0.125f; qhi[e] *= 0.125f; } }
        float qp[8], qm[8], kp[8], km[8], qe[8];
#pragma unroll
        for (int e = 0; e < 4; ++e) {
            const int c0 = 4 * g + e, c1 = c0 + 32;
            const float b0 = BS[j * 65 + c0], b1 = BS[j * 65 + c1], r0 = BS[32 * 65 + c0], r1 = BS[32 * 65 + c1];
            const float p0 = __expf(b0 - r0), m0 = __expf(r0 - b0), p1 = __expf(b1 - r1), m1 = __expf(r1 - b1), e0 = __expf(b0), e1 = __expf(b1);
            qp[e] = qlo[e] * p0; qm[e] = qlo[e] * m0; kp[e] = klo[e] * p0; km[e] = klo[e] * m0; qe[e] = qlo[e] * e0;
            qp[4 + e] = qhi[e] * p1; qm[4 + e] = qhi[e] * m1; kp[4 + e] = khi[e] * p1; km[4 + e] = khi[e] * m1; qe[4 + e] = qhi[e] * e1;
        }
        const int o0 = j * PB + 8 * g, o1 = o0 + 64;
#define ST8(OFF, A) do { *(LAS v2u*)(lds + (OFF) + o0) = (v2u){pk2(A[0], A[1]), pk2(A[2], A[3])}; *(LAS v2u*)(lds + (OFF) + o1) = (v2u){pk2(A[4], A[5]), pk2(A[6], A[7])}; } while (0)
        ST8(L_QP, qp); ST8(L_QM, qm); ST8(L_KP, kp); ST8(L_KM, km); ST8(L_QE, qe);
#undef ST8
    }
    stage_vt(lds, I, proj, tid);
    __syncthreads();
    {
        const int jt = w & 3;
#pragma unroll
        for (int ii = 0; ii < 2; ++ii) {
            const int it = (w >> 2) * 2 + ii;
            f32x4 lo = {0.f, 0.f, 0.f, 0.f}, hi = {0.f, 0.f, 0.f, 0.f};
#pragma unroll
            for (int kk = 0; kk < 2; ++kk) { lo = MFMA16(frag_plain(lds + L_KM, jt, kk, lane), frag_plain(lds + L_QP, it, kk, lane), lo);
                                             hi = MFMA16(frag_plain(lds + L_KP, jt, kk, lane), frag_plain(lds + L_QM, it, kk, lane), hi); }
            const int i = 16 * it + (lane & 15), j0 = 16 * jt + 4 * (lane >> 4);
            float s[4];
#pragma unroll
            for (int e = 0; e < 4; ++e) s[e] = (j0 + e <= i) ? lo[e] : hi[e];
            *(LAS v2u*)(lds + L_PS + i * PB + j0 * 2) = (v2u){pk2(s[0], s[1]), pk2(s[2], s[3])};
        }
    }
    __syncthreads();
    {
        const int it = w & 3, vh = w >> 2; const bf16* STu = ST + (size_t)u * 8192;
        f32x4 acc[4];
#pragma unroll
        for (int a = 0; a < 4; ++a) acc[a] = (f32x4){0.f, 0.f, 0.f, 0.f};
#pragma unroll
        for (int kk = 0; kk < 2; ++kk) {
            const bf16x8 y1 = frag_plain(lds + L_PS, it, kk, lane), y2 = frag_plain(lds + L_QE, it, kk, lane);
#pragma unroll
            for (int a = 0; a < 4; ++a) { const int vt = 4 * vh + a;
                const bf16x8 x2 = *(const bf16x8*)(STu + (16 * vt + (lane & 15)) * 64 + 32 * kk + 8 * (lane >> 4));
                acc[a] = MFMA16(frag_swz(lds + L_VT, vt, kk, lane), y1, acc[a]);
                acc[a] = MFMA16(x2, y2, acc[a]); }
        }
        float ss = 0.f;
#pragma unroll
        for (int a = 0; a < 4; ++a) ss += (acc[a].x * acc[a].x + acc[a].y * acc[a].y) + (acc[a].z * acc[a].z + acc[a].w * acc[a].w);
        ss += __shfl_xor(ss, 16); ss += __shfl_xor(ss, 32);
        const int i = 16 * it + (lane & 15);
        if ((lane >> 4) == 0) RED[i * 2 + vh] = ss;
        __syncthreads();
        const float r = 1.0f / sqrtf((RED[i * 2] + RED[i * 2 + 1]) * (1.f / 128.f) + RMS_EPS);
        const float* ng = (I.gla ? ng_gla : ng_ret) + 128 * I.h;
        const bf16* grow = proj + (I.m0 + i) * LDP + I.gcol; bf16* orow = O + (I.m0 + i) * D + I.ocol;
#pragma unroll
        for (int a = 0; a < 4; ++a) { const int v0 = 16 * (4 * vh + a) + 4 * (lane >> 4);
            const v2u gv = *(const v2u*)(grow + v0); const f32x4 g4 = *(const f32x4*)(ng + v0);
            const float o0 = acc[a].x * r * g4.x * silu_f(bflo(gv.x)), o1 = acc[a].y * r * g4.y * silu_f(bfhi(gv.x)), o2 = acc[a].z * r * g4.z * silu_f(bflo(gv.y)), o3 = acc[a].w * r * g4.w * silu_f(bfhi(gv.y));
            *(v2u*)(orow + v0) = (v2u){pk2(o0, o1), pk2(o2, o3)}; }
    }
}

struct Args { const float* in[17]; float* out; unsigned char* ws; int ph_lo, ph_hi; };
constexpr int N_PHASES = 13;
__global__ void __launch_bounds__(NTHR, 2) fwd_kernel(Args a) {
    extern __shared__ __attribute__((aligned(16))) unsigned char lds_raw[];
    LAS unsigned char* lds = (LAS unsigned char*)lds_raw;
    cg::grid_group grid = cg::this_grid();
    const int tid = threadIdx.x, lane = tid & 63, wave = __builtin_amdgcn_readfirstlane(tid >> 6);
    const int G = gridDim.x, bx = blockIdx.x;
    const int gw = bx * NWAVES + wave, NGW = G * NWAVES;
    const long gt = (long)bx * NTHR + tid, NGT = (long)G * NTHR;
    unsigned char* ws = a.ws;
    const float* x = a.in[0];
    const float *ffn1_g = a.in[1], *ffn1_wg = a.in[2], *ffn1_wu = a.in[3], *ffn1_wd = a.in[4], *mix_g = a.in[5], *w_in = a.in[6], *ret_ng = a.in[7], *w_a2 = a.in[8], *b_a = a.in[9],
                *gla_ng = a.in[10], *w_out = a.in[11], *ffn2_g = a.in[12], *ffn2_wg = a.in[13], *ffn2_wu = a.in[14], *ffn2_wd = a.in[15], *fin_g = a.in[16];
    float* out = a.out;
    bf16 *Wgu1 = (bf16*)(ws + WS_WGU1), *Wd1 = (bf16*)(ws + WS_WD1), *Win = (bf16*)(ws + WS_WIN), *Wout = (bf16*)(ws + WS_WOUT), *Wgu2 = (bf16*)(ws + WS_WGU2), *Wd2 = (bf16*)(ws + WS_WD2);
    float* TAB = (float*)(ws + WS_TAB); float* DEC = (float*)(ws + WS_DEC); bf16* H = (bf16*)(ws + WS_H); bf16* STb = (bf16*)(ws + WS_ST);
    bf16* PROJ = (bf16*)(ws + WS_PROJ); bf16* ACT = (bf16*)(ws + WS_ACT); float* KV = (float*)(ws + WS_KV); bf16* Ob = (bf16*)(ws + WS_O);
    const int lo = a.ph_lo, hi = a.ph_hi;
#define IN(k) (lo <= (k) && (k) < hi)
#define SEAM(k) do { if (IN(k) && IN((k) + 1)) grid.sync(); } while (0)

    if (IN(0)) {
        LAS float* scr = (LAS float*)(lds + wave * 16384);
        constexpr int I_G = (D / 64) * (FF / 32), I_D = (FF / 64) * (D / 32), I_IN = (D / 64) * 97, I_O = (D / 64) * (D / 32);
        constexpr int NITEMS = 6 * I_G + I_IN + I_O;
        static_assert(I_G == I_D, "items");
        for (int it = gw; it < NITEMS; it += NGW) {
            int r = it;
            if (r < I_G) { transpose_item(ffn1_wg, D, FF, Wgu1, FF / 32, 1, scr, r, lane); continue; } r -= I_G;
            if (r < I_G) { transpose_item(ffn1_wu, D, FF, Wgu1, FF / 32, 2, scr, r, lane); continue; } r -= I_G;
            if (r < I_D) { transpose_item(ffn1_wd, FF, D, Wd1, D / 32, 0, scr, r, lane); continue; } r -= I_D;
            if (r < I_G) { transpose_item(ffn2_wg, D, FF, Wgu2, FF / 32, 1, scr, r, lane); continue; } r -= I_G;
            if (r < I_G) { transpose_item(ffn2_wu, D, FF, Wgu2, FF / 32, 2, scr, r, lane); continue; } r -= I_G;
            if (r < I_D) { transpose_item(ffn2_wd, FF, D, Wd2, D / 32, 0, scr, r, lane); continue; } r -= I_D;
            if (r < I_IN) { transpose_item(w_in, D, INW, Win, 97, 0, scr, r, lane); continue; } r -= I_IN;
            transpose_item(w_out, D, D, Wout, D / 32, 0, scr, r, lane);
        }
        { v4u* z = (v4u*)(Win + (size_t)3104 * D); const long nz = (long)(LDP - 3104) * D * 2 / 16; for (long i = gt; i < nz; i += NGT) z[i] = (v4u){0u, 0u, 0u, 0u}; }
        for (long i = gt; i < (long)T * 32; i += NGT) { const int pos = (int)(i >> 5), f = (int)(i & 31);
            const float inv = powf(10000.0f, -(float)f * (1.0f / 32.0f)); const float ang = (float)pos * inv;
            *(f32x2v*)(TAB + 2 * i) = (f32x2v){cosf(ang), sinf(ang)}; }
        for (int m = gw; m < M; m += NGW) norm_row_bf16(x + (size_t)m * D, ffn1_g, H + (size_t)m * D, lane);
    }
    SEAM(0);
    if (IN(1)) { pg8::Gemm g{H, Wgu1, M, NGU, D}; pg8::StaticOrder S; S.init(M, NGU, G, bx); EpiSwiGLU E{ACT, FF};
        pg8::gemm_phase<EpiSwiGLU, pg8::StaticOrder, PG8_ALIGN, PG8_SP2>(lds, g, S, E); }
    SEAM(1);
    if (IN(2)) { pg8::Gemm g{ACT, Wd1, M, D, FF}; pg8::StaticOrder S; S.init(M, D, G, bx); EpiResid E{x, out, D, 0.5f};
        pg8::gemm_phase<EpiResid, pg8::StaticOrder, PG8_ALIGN, PG8_SP2>(lds, g, S, E); }
    SEAM(2);
    if (IN(3)) { for (int m = gw; m < M; m += NGW) norm_row_bf16(out + (size_t)m * D, mix_g, H + (size_t)m * D, lane); }
    SEAM(3);
    if (IN(4)) { pg8::Gemm g{H, Win, M, LDP, D}; pg8::StaticOrder S; S.init(M, LDP, G, bx); pg8::EpiBf16<0> E{PROJ, LDP, nullptr, 0, 0, 1.f};
        pg8::gemm_phase<pg8::EpiBf16<0>, pg8::StaticOrder, PG8_ALIGN, PG8_SP2>(lds, g, S, E); }
    SEAM(4);
    if (IN(5)) { for (int u = bx; u < NUNITS; u += G) attn_pass_a(lds, u, PROJ, TAB, w_a2, b_a, KV, DEC, tid); }
    SEAM(5);
    if (IN(6)) {
        for (long e2 = gt; e2 < (long)BATCH * 8 * 4096; e2 += NGT) {
            const int bh = (int)(e2 >> 12), el = (int)(e2 & 4095) * 2, k = el & 63;
            float r0 = 0.f, r1 = 0.f;
            for (int n0 = 0; n0 < NCH; n0 += 8) {
                f32x2v kv[8], dc[8];
#pragma unroll
                for (int q = 0; q < 8; ++q) { const size_t uu = (size_t)bh * 64 + n0 + q; kv[q] = *(const f32x2v*)(KV + uu * 8192 + el); dc[q] = *(const f32x2v*)(DEC + uu * 64 + k); }
#pragma unroll
                for (int q = 0; q < 8; ++q) { const size_t uu = (size_t)bh * 64 + n0 + q; *(unsigned*)(STb + uu * 8192 + el) = pk2(r0, r1); r0 = dc[q].x * r0 + kv[q].x; r1 = dc[q].y * r1 + kv[q].y; }
            }
        }
    }
    SEAM(6);
    if (IN(7)) { for (int u = bx; u < NUNITS; u += G) attn_pass_c(lds, u, PROJ, TAB, w_a2, b_a, STb, ret_ng, gla_ng, Ob, tid); }
    SEAM(7);
    if (IN(8)) { pg8::Gemm g{Ob, Wout, M, D, D}; pg8::StaticOrder S; S.init(M, D, G, bx); EpiResid E{out, out, D, 1.0f};
        pg8::gemm_phase<EpiResid, pg8::StaticOrder, PG8_ALIGN, PG8_SP2>(lds, g, S, E); }
    SEAM(8);
    if (IN(9)) { for (int m = gw; m < M; m += NGW) norm_row_bf16(out + (size_t)m * D, ffn2_g, H + (size_t)m * D, lane); }
    SEAM(9);
    if (IN(10)) { pg8::Gemm g{H, Wgu2, M, NGU, D}; pg8::StaticOrder S; S.init(M, NGU, G, bx); EpiSwiGLU E{ACT, FF};
        pg8::gemm_phase<EpiSwiGLU, pg8::StaticOrder, PG8_ALIGN, PG8_SP2>(lds, g, S, E); }
    SEAM(10);
    if (IN(11)) { pg8::Gemm g{ACT, Wd2, M, D, FF}; pg8::StaticOrder S; S.init(M, D, G, bx); EpiResid E{out, out, D, 0.5f};
        pg8::gemm_phase<EpiResid, pg8::StaticOrder, PG8_ALIGN, PG8_SP2>(lds, g, S, E); }
    SEAM(11);
    if (IN(12)) { for (int m = gw; m < M; m += NGW) norm_row_f32(out + (size_t)m * D, fin_g, lane); }
#undef IN
#undef SEAM
}

#ifndef MK_N_LAUNCHES
#define MK_N_LAUNCHES 1
#endif
extern "C" void kernel_launch(void* const* d_in, const int* in_sizes, int n_in, void* d_out, int out_size, void* d_ws, size_t ws_size, hipStream_t stream) {
    static int grid = 0;
    if (grid == 0) {
        if (n_in != 17 || in_sizes[0] != M * D || out_size != M * D || ws_size < WS_END) { fprintf(stderr, "kernel_launch: unexpected shapes (n_in %d, in0 %d, out %d, ws %zu)\n", n_in, n_in > 0 ? in_sizes[0] : -1, out_size, ws_size); grid = -1; return; }
        int dev = 0, cus = 0, per_cu = 0;
        if (hipGetDevice(&dev) != hipSuccess || hipDeviceGetAttribute(&cus, hipDeviceAttributeMultiprocessorCount, dev) != hipSuccess) { grid = -1; return; }
        if (hipFuncSetAttribute((const void*)fwd_kernel, hipFuncAttributeMaxDynamicSharedMemorySize, LDS_BYTES) != hipSuccess) { fprintf(stderr, "kernel_launch: hipFuncSetAttribute failed\n"); grid = -1; return; }
        if (hipOccupancyMaxActiveBlocksPerMultiprocessor(&per_cu, (const void*)fwd_kernel, NTHR, LDS_BYTES) != hipSuccess || per_cu < 1) { fprintf(stderr, "kernel_launch: occupancy query says %d\n", per_cu); per_cu = 1; }
        (void)hipGetLastError();
        grid = cus * per_cu;
    }
    if (grid < 0) return;
    Args a{};
    for (int i = 0; i < 17; ++i) a.in[i] = (const float*)d_in[i];
    a.out = (float*)d_out; a.ws = (unsigned char*)d_ws;
#if MK_N_LAUNCHES == 1
    a.ph_lo = 0; a.ph_hi = N_PHASES;
    void* args[] = {&a};
    hipError_t e = hipLaunchCooperativeKernel((const void*)fwd_kernel, dim3(grid), dim3(NTHR), args, LDS_BYTES, stream);
    if (e != hipSuccess) fprintf(stderr, "cooperative launch failed: %s (grid %d)\n", hipGetErrorString(e), grid);
#else
    for (int p = 0; p < N_PHASES; ++p) { a.ph_lo = p; a.ph_hi = p + 1; hipLaunchKernelGGL(fwd_kernel, dim3(grid), dim3(NTHR), LDS_BYTES, stream, a); }
#endif
}
```

```cpp
#include <hip/hip_runtime.h>
#include <cstdio>
#include <cstdint>
#include <hip/hip_cooperative_groups.h>
namespace pg8 {
#define PG8_LAS __attribute__((address_space(3)))
typedef unsigned short bf16_t;
typedef short bf16x8 __attribute__((ext_vector_type(8)));
typedef float f32x4 __attribute__((ext_vector_type(4)));
typedef unsigned u32x4 __attribute__((ext_vector_type(4)));
constexpr int BM = 256, BK = 64, HALF = 128, HTB = HALF * BK * 2  , STAGE_BYTES = 8 * HTB, NXCD = 8, WGM = 8;

__host__ __device__ __forceinline__ int lds_byte(int r, int c) { const int st = (r >> 4) * 2 + (c >> 5), rr = r & 15, cc = c & 31, ob = rr * 64 + cc * 2; return st * 1024 + (ob ^ (((ob >> 9) & 1) << 5)); }
__host__ __device__ __forceinline__ void stage_rc(int b, int& R, int& C) { const int st = b / 1024, sb = b % 1024, swz = sb ^ (((sb >> 9) & 1) << 5); R = (st >> 1) * 16 + swz / 64; C = (st & 1) * 32 + (swz % 64) / 2; }
__host__ __device__ __forceinline__ int perm32(int rho) { const int n = rho >> 4, i = rho & 15; return 8 * (i >> 2) + 4 * n + (i & 3); }

struct Unit { int pm, pn; };
struct Gemm { const bf16_t* A; const bf16_t* Bt; int M, N, K; };

struct StaticOrder {
    int nM, nN, nwg, G, c;
    __host__ __device__ void init(int M, int N, int G_, int c_) { nM = M / BM; nN = N / BM; nwg = nM * nN; G = G_; c = c_; }
    __host__ __device__ bool next(int i, Unit& u) const {
        const long L = (long)i * G + c; if (L >= nwg) return false;
        int wgid = (int)L; { const int q = nwg / NXCD, r = nwg % NXCD, xcd = wgid % NXCD, off = wgid / NXCD; wgid = (xcd < r ? xcd * (q + 1) : r * (q + 1) + (xcd - r) * q) + off; }
        const int nig = WGM * nN, gid = wgid / nig, fm = gid * WGM, gsz = (nM - fm) < WGM ? (nM - fm) : WGM;
        u.pm = fm + ((wgid % nig) % gsz); u.pn = (wgid % nig) / gsz; return true;
    }
    __device__ __forceinline__ void a_ready(const Unit&) const {}
    __device__ __forceinline__ void done(const Unit&) const {}
};

__device__ __forceinline__ unsigned cvt_pk_bf16(float lo, float hi) { unsigned r; asm volatile("v_cvt_pk_bf16_f32 %0, %1, %2" : "=v"(r) : "v"(lo), "v"(hi)); return r; }
typedef float f32x2 __attribute__((ext_vector_type(2)));
__device__ __forceinline__ f32x2 gelu_pk(f32x2 v) {
    const f32x2 av = __builtin_elementwise_abs(v), d = av * 0.2316418882f + 1.0f;
    f32x2 t; t.x = __builtin_amdgcn_rcpf(d.x); t.y = __builtin_amdgcn_rcpf(d.y);
    f32x2 q = t * 0.5307027145f + (-0.7265760135f); q = q * t + 0.7107068705f; q = q * t + (-0.142248368f); q = q * t + 0.127414796f; q = q * t;
    const f32x2 s = (v * v) * (-0.72134752044f);
    f32x2 e; e.x = __builtin_amdgcn_exp2f(s.x); e.y = __builtin_amdgcn_exp2f(s.y);
    const f32x2 m = v * (q * e), r = v - m;
    f32x2 o; o.x = v.x < 0.f ? m.x : r.x; o.y = v.y < 0.f ? m.y : r.y; return o;
}

template <int ACT  > struct EpiBf16 {
    static constexpr bool PERM = true, AFTER_DRAIN = false; static_assert(ACT == 0 || ACT == 1, "EpiBf16: ACT is 0 (none) or 1 (gelu_pk)");
    bf16_t* O; int ldc; const float* bias; int split_cols; size_t split_stride; float scale0;
    __device__ __forceinline__ void operator()(const f32x4 (&acc)[2][2][4][2], const Unit& u, int wr, int wc, int fr, int fq) const {
        const int row0 = u.pm * BM + wr * 64 + fr; int colt = u.pn * BM; bf16_t* base = O;
        float sc = 1.f; if (split_cols) { const int t = colt / split_cols; base += (size_t)t * split_stride; colt -= t * split_cols; if (t == 0) sc = scale0; }
        const int col0 = colt + wc * 32 + 8 * fq, bcol0 = u.pn * BM + wc * 32 + 8 * fq;
        f32x4 bv[2][2];
#pragma unroll
        for (int bj = 0; bj < 2; ++bj)
#pragma unroll
            for (int n = 0; n < 2; ++n) bv[bj][n] = bias ? *(const f32x4*)(bias + bcol0 + bj * HALF + 4 * n) : (f32x4){0.f, 0.f, 0.f, 0.f};
#pragma unroll
        for (int ai = 0; ai < 2; ++ai)
#pragma unroll
            for (int m = 0; m < 4; ++m) { bf16_t* rowp = base + (size_t)(row0 + ai * HALF + m * 16) * ldc + col0;
#pragma unroll
                for (int bj = 0; bj < 2; ++bj) { f32x4 v0 = acc[ai][bj][m][0] + bv[bj][0], v1 = acc[ai][bj][m][1] + bv[bj][1];
                    if (ACT == 1) { f32x2 a = gelu_pk((f32x2){v0[0], v0[1]}), b = gelu_pk((f32x2){v0[2], v0[3]}), c = gelu_pk((f32x2){v1[0], v1[1]}), d = gelu_pk((f32x2){v1[2], v1[3]});
                        v0 = (f32x4){a.x, a.y, b.x, b.y}; v1 = (f32x4){c.x, c.y, d.x, d.y}; }
                    v0 = v0 * sc; v1 = v1 * sc; u32x4 w; w.x = cvt_pk_bf16(v0[0], v0[1]); w.y = cvt_pk_bf16(v0[2], v0[3]); w.z = cvt_pk_bf16(v1[0], v1[1]); w.w = cvt_pk_bf16(v1[2], v1[3]);
                    *(u32x4*)(rowp + bj * HALF) = w; } }
    }
};
template <class Epi, class Sched, bool ALIGN_EPI = false, bool SP2 = false>
__device__ __forceinline__ void gemm_phase(PG8_LAS unsigned char* lds, const Gemm g, const Sched& S, const Epi& E) {
    const int tid = threadIdx.x, wid = __builtin_amdgcn_readfirstlane(tid >> 6), lane = tid & 63, wr = wid >> 2, wc = wid & 3, fr = lane & 15, fq = lane >> 4;
    const int K = g.K, nt = K / BK;
    unsigned voffA[2], voffB[2];
#pragma unroll
    for (int i = 0; i < 2; ++i) { int R, C; stage_rc(tid * 16 + i * 8192, R, C); const int Rb = Epi::PERM ? ((R & ~31) + perm32(R & 31)) : R;
        voffA[i] = (unsigned)(R * K + C) * 2u; voffB[i] = (unsigned)(Rb * K + C) * 2u; }
    const size_t kstep = (size_t)(BK * 2);
    const size_t hstep = (size_t)HALF * K * 2;
    const size_t tstep = 2 * hstep;
    const unsigned ldsw = (unsigned)wid * 1024u;
    const int aoff = lds_byte(wr * 64 + fr, fq * 8), boff = lds_byte(wc * 32 + fr, fq * 8);
#define PG8_SA(b, h) (((b) * 2 + (h)) * HTB)
#define PG8_SB(b, h) ((4 + (b) * 2 + (h)) * HTB)
#define PG8_STAGE(bufoff, gbase, voff) do { _Pragma("unroll") for (int _i = 0; _i < 2; ++_i) \
        __builtin_amdgcn_global_load_lds((const unsigned*)((const char*)(gbase) + (voff)[_i]), (PG8_LAS unsigned*)(lds + (bufoff) + ldsw + _i * 8192), 16, 0, 0); } while (0)
#define PG8_LDA(dst, b, h) do { _Pragma("unroll") for (int m = 0; m < 4; ++m) _Pragma("unroll") for (int k = 0; k < 2; ++k) dst[m][k] = *(const PG8_LAS bf16x8*)(lds + PG8_SA(b, h) + aoff + m * 2048 + k * 1024); } while (0)
#define PG8_LDB(dst, b, h) do { _Pragma("unroll") for (int n = 0; n < 2; ++n) _Pragma("unroll") for (int k = 0; k < 2; ++k) dst[n][k] = *(const PG8_LAS bf16x8*)(lds + PG8_SB(b, h) + boff + n * 2048 + k * 1024); } while (0)
#define PG8_MMA(ai, bj, At, Bt) do { __builtin_amdgcn_s_setprio(1); _Pragma("unroll") for (int m = 0; m < 4; ++m) _Pragma("unroll") for (int n = 0; n < 2; ++n) _Pragma("unroll") for (int k = 0; k < 2; ++k) \
        acc[ai][bj][m][n] = __builtin_amdgcn_mfma_f32_16x16x32_bf16(Bt[n][k], At[m][k], acc[ai][bj][m][n], 0, 0, 0); __builtin_amdgcn_s_setprio(0); } while (0)
#define PG8_WAIT_V(n) asm volatile("s_waitcnt vmcnt(" #n ")" ::: "memory")
#define PG8_WAIT_L(n) asm volatile("s_waitcnt lgkmcnt(" #n ")" ::: "memory")
#define PG8_BAR __builtin_amdgcn_s_barrier()
#define PG8_SCHED __builtin_amdgcn_sched_barrier(0)
    Unit cur, nxt; int ui = 0;
    if (!S.next(0, cur)) return;
    f32x4 acc[2][2][4][2];
#pragma unroll
    for (int a = 0; a < 2; ++a)
#pragma unroll
        for (int b = 0; b < 2; ++b)
#pragma unroll
            for (int m = 0; m < 4; ++m)
#pragma unroll
                for (int n = 0; n < 2; ++n) acc[a][b][m][n] = (f32x4){0.f, 0.f, 0.f, 0.f};
    bf16x8 At[4][2], B0[2][2], B1[2][2];
    const char* cA = (const char*)g.A + (size_t)cur.pm * tstep; const char* cB = (const char*)g.Bt + (size_t)cur.pn * tstep;
    S.a_ready(cur);
    if constexpr (SP2) {
        PG8_STAGE(PG8_SB(0, 0), cB, voffB); PG8_STAGE(PG8_SB(0, 1), cB + hstep, voffB); PG8_STAGE(PG8_SA(0, 0), cA, voffA); PG8_STAGE(PG8_SA(0, 1), cA + hstep, voffA);
        if (wr == 1) PG8_BAR;
        PG8_WAIT_V(2); PG8_BAR;
        PG8_STAGE(PG8_SB(1, 0), cB + kstep, voffB); PG8_STAGE(PG8_SA(1, 0), cA + kstep, voffA); PG8_STAGE(PG8_SB(1, 1), cB + hstep + kstep, voffB);
        PG8_WAIT_V(6); PG8_BAR;
    } else {
        PG8_STAGE(PG8_SB(0, 0), cB, voffB); PG8_STAGE(PG8_SA(0, 0), cA, voffA); PG8_STAGE(PG8_SB(0, 1), cB + hstep, voffB); PG8_STAGE(PG8_SA(0, 1), cA + hstep, voffA);
        if (wr == 1) PG8_BAR;
        PG8_WAIT_V(4); PG8_BAR;
        PG8_STAGE(PG8_SB(1, 0), cB + kstep, voffB); PG8_STAGE(PG8_SA(1, 0), cA + kstep, voffA); PG8_STAGE(PG8_SB(1, 1), cB + hstep + kstep, voffB);
        PG8_WAIT_V(6); PG8_BAR;
    }
    for (;;) {
        const bool has_next = S.next(ui + 1, nxt);
        const char* nA = has_next ? (const char*)g.A + (size_t)nxt.pm * tstep : cA; const char* nB = has_next ? (const char*)g.Bt + (size_t)nxt.pn * tstep : cB;
        for (int t = 0; t < nt; t += 2) {
            const bool last = (t == nt - 2);
            const char* a1 = cA + (size_t)(t + 1) * kstep;
            const char* a2 = last ? nA : cA + (size_t)(t + 2) * kstep; const char* b2 = last ? nB : cB + (size_t)(t + 2) * kstep;
            const char* a3 = a2 + kstep; const char* b3 = b2 + kstep;
            if (last && has_next) S.a_ready(nxt);
            if constexpr (SP2) {
            PG8_LDB(B0, 0, 0); PG8_LDB(B1, 0, 1); PG8_SCHED; PG8_LDA(At, 0, 0); PG8_STAGE(PG8_SA(1, 1), a1 + hstep, voffA);
            PG8_WAIT_V(8); PG8_WAIT_L(0); PG8_BAR; PG8_MMA(0, 0, At, B0); PG8_MMA(0, 1, At, B1); PG8_BAR; PG8_SCHED;
            PG8_LDA(At, 0, 1); PG8_STAGE(PG8_SB(0, 0), b2, voffB); PG8_STAGE(PG8_SB(0, 1), b2 + hstep, voffB); PG8_STAGE(PG8_SA(0, 0), a2, voffA);
            PG8_WAIT_V(8); PG8_WAIT_L(0); PG8_BAR; PG8_MMA(1, 0, At, B0); PG8_MMA(1, 1, At, B1); PG8_BAR; PG8_SCHED;
            PG8_LDB(B0, 1, 0); PG8_LDB(B1, 1, 1); PG8_SCHED; PG8_LDA(At, 1, 0); PG8_STAGE(PG8_SA(0, 1), a2 + hstep, voffA);
            PG8_WAIT_V(8); PG8_WAIT_L(0); PG8_BAR; PG8_MMA(0, 0, At, B0); PG8_MMA(0, 1, At, B1); PG8_BAR; PG8_SCHED;
            PG8_LDA(At, 1, 1); PG8_STAGE(PG8_SB(1, 0), b3, voffB); PG8_STAGE(PG8_SB(1, 1), b3 + hstep, voffB); PG8_STAGE(PG8_SA(1, 0), a3, voffA);
            PG8_WAIT_V(8); PG8_WAIT_L(0); PG8_BAR; PG8_MMA(1, 0, At, B0); PG8_MMA(1, 1, At, B1); PG8_BAR; PG8_SCHED;
            } else {
            PG8_LDB(B0, 0, 0); PG8_SCHED; PG8_LDA(At, 0, 0); PG8_STAGE(PG8_SA(1, 1), a1 + hstep, voffA);
            PG8_WAIT_L(8); PG8_BAR; PG8_WAIT_L(0); PG8_MMA(0, 0, At, B0); PG8_BAR; PG8_SCHED;
            PG8_LDB(B1, 0, 1); PG8_STAGE(PG8_SB(0, 0), b2, voffB);
            PG8_BAR; PG8_WAIT_L(0); PG8_MMA(0, 1, At, B1); PG8_BAR;
            PG8_LDA(At, 0, 1); PG8_STAGE(PG8_SA(0, 0), a2, voffA);
            PG8_BAR; PG8_WAIT_L(0); PG8_MMA(1, 0, At, B0); PG8_BAR; PG8_SCHED;
            PG8_STAGE(PG8_SB(0, 1), b2 + hstep, voffB);
            PG8_WAIT_V(6); PG8_BAR; PG8_MMA(1, 1, At, B1); PG8_BAR;
            PG8_LDB(B0, 1, 0); PG8_SCHED; PG8_LDA(At, 1, 0); PG8_STAGE(PG8_SA(0, 1), a2 + hstep, voffA);
            PG8_WAIT_L(8); PG8_BAR; PG8_WAIT_L(0); PG8_MMA(0, 0, At, B0); PG8_BAR; PG8_SCHED;
            PG8_LDB(B1, 1, 1); PG8_STAGE(PG8_SB(1, 0), b3, voffB);
            PG8_BAR; PG8_WAIT_L(0); PG8_MMA(0, 1, At, B1); PG8_BAR;
            PG8_LDA(At, 1, 1); PG8_STAGE(PG8_SA(1, 0), a3, voffA);
            PG8_BAR; PG8_WAIT_L(0); PG8_MMA(1, 0, At, B0); PG8_BAR; PG8_SCHED;
            PG8_STAGE(PG8_SB(1, 1), b3 + hstep, voffB);
            PG8_WAIT_V(6); PG8_BAR; PG8_MMA(1, 1, At, B1); PG8_BAR;
            }
        }
        if constexpr (ALIGN_EPI) { if (wr == 0) PG8_BAR; }
        if constexpr (!Epi::AFTER_DRAIN) { E(acc, cur, wr, wc, fr, fq); S.done(cur); }
        if (!has_next) break;
#pragma unroll
        for (int a = 0; a < 2; ++a)
#pragma unroll
            for (int b = 0; b < 2; ++b)
#pragma unroll
                for (int m = 0; m < 4; ++m)
#pragma unroll
                    for (int n = 0; n < 2; ++n) acc[a][b][m][n] = (f32x4){0.f, 0.f, 0.f, 0.f};
        cur = nxt; cA = nA; cB = nB; ++ui;
        if constexpr (ALIGN_EPI) { if (wr == 1) PG8_BAR; }
    }
    PG8_WAIT_V(0);
    if constexpr (!ALIGN_EPI) { if (wr == 0) PG8_BAR; }
    PG8_BAR;
    if constexpr (Epi::AFTER_DRAIN) { E.fused(acc, cur, wr, wc, fr, fq, lds, wid, lane); S.done(cur); }
#undef PG8_SA
#undef PG8_SB
#undef PG8_STAGE
#undef PG8_LDA
#undef PG8_LDB
#undef PG8_MMA
#undef PG8_WAIT_V
#undef PG8_WAIT_L
#undef PG8_BAR
#undef PG8_SCHED
}
}

#ifndef PG8_SP2
#define PG8_SP2 true
#endif
#ifndef PG8_ALIGN
#define PG8_ALIGN true
#endif
namespace cg = cooperative_groups;
#define GAS __attribute__((address_space(1)))
#define LAS __attribute__((address_space(3)))
typedef unsigned short bf16;
typedef unsigned v4u __attribute__((ext_vector_type(4)));
typedef unsigned v2u __attribute__((ext_vector_type(2)));
typedef float f32x4 __attribute__((ext_vector_type(4)));
typedef float f32x2v __attribute__((ext_vector_type(2)));
typedef short bf16x8 __attribute__((ext_vector_type(8)));

constexpr int NWAVES = 8, NTHR = 512;
constexpr int BATCH = 4, T = 4096, D = 1024, M = BATCH * T, FF = 2816, NGU = 2 * FF, INW = 3088, LDP = 3328, CH = 64, NCH = T / CH;
constexpr int NUNITS = BATCH * 8 * NCH;
constexpr float RMS_EPS = 1e-6f;
constexpr size_t MiB = 1u << 20;
constexpr size_t WS_WGU1 = 0, WS_WD1 = 11 * MiB, WS_WIN = 33 * MiB / 2, WS_WOUT = 23 * MiB, WS_WGU2 = 25 * MiB, WS_WD2 = 36 * MiB;
constexpr size_t WS_TAB = 42 * MiB, WS_DEC = 43 * MiB, WS_H = 46 * MiB, WS_ST = WS_H, WS_PROJ = 78 * MiB, WS_ACT = WS_PROJ, WS_KV = 182 * MiB, WS_O = WS_KV, WS_END = 246 * MiB;
static_assert(WS_WD1 + (size_t)D * FF * 2 <= WS_WIN && WS_WIN + (size_t)LDP * D * 2 <= WS_WOUT && WS_WD2 + (size_t)D * FF * 2 <= WS_TAB, "ws map");
static_assert(WS_PROJ + (size_t)M * LDP * 2 <= WS_KV && WS_KV + (size_t)NUNITS * 8192 * 4 <= WS_END, "ws map");
constexpr size_t WS_CTL = 44 * MiB, CTL_BYTES = 16384;
constexpr int LDS_BYTES = 147456, MISC_OFF = 131072 + 64;
constexpr int PB = 144;
constexpr int L_QP = 0, L_QM = 9216, L_KP = 18432, L_KM = 27648, L_QE = 36864, L_VT = 46080, L_PS = 64512, L_BS = 73728, L_LOW = 90368, L_TOT = 94464, L_RED = 96512, L_KDT = 0;

__device__ __forceinline__ unsigned pk2(float lo, float hi) { return pg8::cvt_pk_bf16(lo, hi); }
__device__ __forceinline__ float bf2f(unsigned h) { return __builtin_bit_cast(float, h << 16); }
__device__ __forceinline__ float bflo(unsigned w) { return __builtin_bit_cast(float, w << 16); }
__device__ __forceinline__ float bfhi(unsigned w) { return __builtin_bit_cast(float, w & 0xffff0000u); }
__device__ __forceinline__ float wave_sum(float v) {
#pragma unroll
    for (int o = 1; o < 64; o <<= 1) v += __shfl_xor(v, o);
    return v;
}
__device__ __forceinline__ float silu_f(float g) { return g * __builtin_amdgcn_rcpf(1.0f + __expf(-g)); }

#define XB_TMO      128
#define XB_XCNT(j)  (256  + 64 * (j))
#define XB_XSUB(j)  (1280 + 64 * (j))
#define XB_XGEN(j)  (2304 + 64 * (j))
#define XB_TOP      3328
#define XB_TOPGEN   3392
#define XCD_BAR_WORDS 3456
#define XB_SPIN_CAP (1u << 18)

__device__ __forceinline__ unsigned xb_ld(unsigned* p)              { return __hip_atomic_load(p, __ATOMIC_RELAXED, __HIP_MEMORY_SCOPE_AGENT); }
__device__ __forceinline__ unsigned xb_add(unsigned* p, unsigned v) { return __hip_atomic_fetch_add(p, v, __ATOMIC_RELAXED, __HIP_MEMORY_SCOPE_AGENT); }
__device__ __forceinline__ unsigned xb_xcc_id() { return (unsigned)__builtin_amdgcn_s_getreg((3 << 11) | 20) & 0xFu; }
#define XB_SPIN(cond, bar) do { unsigned _sp = 0; while (cond) { __builtin_amdgcn_s_sleep(1); \
    if ((++_sp & 255u) == 0u) { if (xb_ld(&(bar)[XB_TMO])) break; if (_sp > XB_SPIN_CAP) { atomicAdd(&(bar)[XB_TMO], 1u); break; } } } } while (0)

struct XcdBarrier {
    unsigned* bar; unsigned x;
    volatile LAS unsigned* st;
};

__device__ __forceinline__ XcdBarrier xcd_barrier_post(unsigned* bar, volatile LAS unsigned* st) {
    XcdBarrier b; b.bar = bar; b.x = xb_xcc_id(); b.st = st;
    if (threadIdx.x == 0) (void)xb_add(&bar[XB_XCNT(b.x)], 1u);
    return b;
}
__device__ __forceinline__ void xcd_barrier_complete(unsigned* bar, unsigned x, unsigned& nloc, unsigned& nx) {
    const unsigned G = gridDim.x * gridDim.y * gridDim.z;
    unsigned sum, cnt, mine, sp = 0u;
    for (;;) {
        sum = 0u; cnt = 0u; mine = 0u;
#pragma unroll
        for (unsigned j = 0; j < 16; ++j) { const unsigned c = xb_ld(&bar[XB_XCNT(j)]); sum += c; cnt += (c > 0u) ? 1u : 0u; mine = (j == x) ? c : mine; }
        if (sum == G) break;
        __builtin_amdgcn_s_sleep(1);
        if ((++sp & 255u) == 0u) { if (xb_ld(&bar[XB_TMO])) break; if (sp > XB_SPIN_CAP) { atomicAdd(&bar[XB_TMO], 1u); break; } }
    }
    nloc = mine > 0u ? mine : 1u; nx = cnt > 0u ? cnt : 1u;
}

__device__ __forceinline__ void xcd_barrier(const XcdBarrier& b) {
    asm volatile("s_waitcnt vmcnt(0)" ::: "memory");
    __syncthreads();
    if (threadIdx.x == 0) {
        unsigned* bar = b.bar;
        __builtin_amdgcn_s_waitcnt(0);
        unsigned nloc = b.st[0], nx = b.st[1];
        if (nloc == 0u) { xcd_barrier_complete(bar, b.x, nloc, nx); b.st[0] = nloc; b.st[1] = nx; }
        const unsigned old = xb_add(&bar[XB_XSUB(b.x)], 1u);
        const unsigned gen = old / nloc;
        if (old + 1u == (gen + 1u) * nloc) {
            __builtin_amdgcn_fence(__ATOMIC_RELEASE, "agent");
            asm volatile("s_waitcnt vmcnt(0)" ::: "memory");
            const unsigned og = xb_add(&bar[XB_TOP], 1u);
            const unsigned tg = og / nx;
            if (og + 1u == (tg + 1u) * nx) xb_add(&bar[XB_TOPGEN], 1u);
            else XB_SPIN(xb_ld(&bar[XB_TOPGEN]) == tg, bar);
            __builtin_amdgcn_fence(__ATOMIC_ACQUIRE, "agent");
            xb_add(&bar[XB_XGEN(b.x)], 1u);
            asm volatile("s_waitcnt vmcnt(0)" ::: "memory");
        } else {
            XB_SPIN(xb_ld(&bar[XB_XGEN(b.x)]) == gen, bar);
            __builtin_amdgcn_fence(__ATOMIC_ACQUIRE, "agent");
            asm volatile("s_waitcnt vmcnt(0)" ::: "memory");
        }
    }
    __syncthreads();
}

struct EpiSwiGLU {
    static constexpr bool PERM = true, AFTER_DRAIN = false;
    bf16* O; int ldc;
    __device__ __forceinline__ void operator()(const pg8::f32x4 (&acc)[2][2][4][2], const pg8::Unit& u, int wr, int wc, int fr, int fq) const {
        const int row0 = u.pm * 256 + wr * 64 + fr, col0 = u.pn * 128 + wc * 32 + 8 * fq;
#pragma unroll
        for (int ai = 0; ai < 2; ++ai)
#pragma unroll
            for (int m = 0; m < 4; ++m) {
                bf16* rowp = O + (size_t)(row0 + ai * 128 + m * 16) * ldc + col0;
                const pg8::f32x4 g0 = acc[ai][0][m][0], g1 = acc[ai][0][m][1], u0 = acc[ai][1][m][0], u1 = acc[ai][1][m][1];
                v4u w;
                w.x = pk2(silu_f(g0[0]) * u0[0], silu_f(g0[1]) * u0[1]); w.y = pk2(silu_f(g0[2]) * u0[2], silu_f(g0[3]) * u0[3]);
                w.z = pk2(silu_f(g1[0]) * u1[0], silu_f(g1[1]) * u1[1]); w.w = pk2(silu_f(g1[2]) * u1[2], silu_f(g1[3]) * u1[3]);
                *(v4u*)rowp = w;
            }
    }
};
struct EpiResid {
    static constexpr bool PERM = false, AFTER_DRAIN = false;
    const float* base; float* out; int ldc; float scale;
    __device__ __forceinline__ void operator()(const pg8::f32x4 (&acc)[2][2][4][2], const pg8::Unit& u, int wr, int wc, int fr, int fq) const {
        const int col0 = u.pn * 256 + wc * 32 + 4 * fq;
#pragma unroll
        for (int ai = 0; ai < 2; ++ai)
#pragma unroll
            for (int m = 0; m < 4; ++m) {
                const size_t off = (size_t)(u.pm * 256 + ai * 128 + wr * 64 + m * 16 + fr) * ldc + col0;
#pragma unroll
                for (int bj = 0; bj < 2; ++bj)
#pragma unroll
                    for (int n = 0; n < 2; ++n) {
                        const pg8::f32x4 bs = *(const pg8::f32x4*)(base + off + bj * 128 + n * 16);
                        *(pg8::f32x4*)(out + off + bj * 128 + n * 16) = bs + acc[ai][bj][m][n] * scale;
                    }
                asm volatile("" ::: "memory");
            }
    }
};

__device__ __forceinline__ void transpose_item(const float* W, int K, int N, bf16* WT, int nblk, int mode, LAS float* scr, int item, int lane) {
    const int kb = item / nblk, nb = item % nblk, k0 = 64 * kb, n0 = 32 * nb;
    const int nn = n0 + (lane & 31); const bool ok = nn < N;
#pragma unroll 8
    for (int i = 0; i < 32; ++i) { const int kk = 2 * i + (lane >> 5); scr[kk * 33 + (lane & 31)] = ok ? W[(size_t)(k0 + kk) * N + nn] : 0.f; }
    asm volatile("s_waitcnt lgkmcnt(0)" ::: "memory");
    const int c = lane & 7;
    const int drow0 = mode == 0 ? n0 : (256 * (n0 >> 7) + (n0 & 127) + (mode == 2 ? 128 : 0));
#pragma unroll
    for (int j = 0; j < 4; ++j) { const int n = (lane >> 3) + 8 * j; const LAS float* s = scr + (8 * c) * 33 + n;
        v4u o; o.x = pk2(s[0 * 33], s[1 * 33]); o.y = pk2(s[2 * 33], s[3 * 33]); o.z = pk2(s[4 * 33], s[5 * 33]); o.w = pk2(s[6 * 33], s[7 * 33]);
        *(v4u*)(WT + (size_t)(drow0 + n) * K + k0 + 8 * c) = o; }
    asm volatile("s_waitcnt lgkmcnt(0)" ::: "memory");
}
__device__ __forceinline__ void norm_row_bf16(const float* xrow, const float* g, bf16* orow, int lane) {
    const f32x4* xr = (const f32x4*)xrow + lane; const f32x4* gr = (const f32x4*)g + lane;
    f32x4 v[4]; float s = 0.f;
#pragma unroll
    for (int j = 0; j < 4; ++j) { v[j] = xr[64 * j]; s += (v[j].x * v[j].x + v[j].y * v[j].y) + (v[j].z * v[j].z + v[j].w * v[j].w); }
    const float r = 1.0f / sqrtf(wave_sum(s) * (1.f / D) + RMS_EPS);
    v2u* o8 = (v2u*)orow + lane;
#pragma unroll
    for (int j = 0; j < 4; ++j) { const f32x4 gg = gr[64 * j]; v2u o; o.x = pk2(v[j].x * r * gg.x, v[j].y * r * gg.y); o.y = pk2(v[j].z * r * gg.z, v[j].w * r * gg.w); o8[64 * j] = o; }
}
__device__ __forceinline__ void norm_row_f32(float* xrow, const float* g, int lane) {
    f32x4* xr = (f32x4*)xrow + lane; const f32x4* gr = (const f32x4*)g + lane;
    f32x4 v[4]; float s = 0.f;
#pragma unroll
    for (int j = 0; j < 4; ++j) { v[j] = xr[64 * j]; s += (v[j].x * v[j].x + v[j].y * v[j].y) + (v[j].z * v[j].z + v[j].w * v[j].w); }
    const float r = 1.0f / sqrtf(wave_sum(s) * (1.f / D) + RMS_EPS);
#pragma unroll
    for (int j = 0; j < 4; ++j) { const f32x4 gg = gr[64 * j]; xr[64 * j] = (f32x4){v[j].x * r * gg.x, v[j].y * r * gg.y, v[j].z * r * gg.z, v[j].w * r * gg.w}; }
}

struct UnitInfo { int b, h8, n, h; bool gla; size_t m0; int qcol, kcol, vcol, gcol, ocol; };
__device__ __forceinline__ UnitInfo unit_info(int u) {
    UnitInfo I; I.n = u & 63; I.h8 = (u >> 6) & 7; I.b = u >> 9; I.gla = I.h8 >= 4; I.h = I.h8 & 3; I.m0 = (size_t)I.b * T + (size_t)I.n * CH;
    const int base = I.gla ? 1536 : 0;
    I.qcol = base + 64 * I.h; I.kcol = base + 256 + 64 * I.h; I.vcol = base + 512 + 128 * I.h; I.gcol = base + 1024 + 128 * I.h; I.ocol = (I.gla ? 512 : 0) + 128 * I.h;
    return I;
}
__device__ __forceinline__ void attn_compute_b(LAS unsigned char* lds, const UnitInfo& I, const bf16* proj, const float* w_a2, const float* b_a, int tid) {
    LAS float* BS = (LAS float*)(lds + L_BS); LAS float* LOW = (LAS float*)(lds + L_LOW); LAS float* TOT = (LAS float*)(lds + L_TOT);
    const int k = tid & 63, w = tid >> 6;
    if (I.gla) {
        { const int j = tid >> 3, r = (tid & 7) * 2; const unsigned v = *(const unsigned*)(proj + (I.m0 + j) * LDP + 3072 + r); LOW[j * 16 + r] = bflo(v); LOW[j * 16 + r + 1] = bfhi(v); }
        float wa[16];
#pragma unroll
        for (int r = 0; r < 16; ++r) wa[r] = w_a2[r * 256 + 64 * I.h + k];
        const float ba = b_a[64 * I.h + k];
        __syncthreads();
        float la[8]; float run = 0.f;
#pragma unroll
        for (int jj = 0; jj < 8; ++jj) {
            const LAS f32x4* lp = (const LAS f32x4*)(LOW + (8 * w + jj) * 16);
            float z = ba;
#pragma unroll
            for (int q = 0; q < 4; ++q) { const f32x4 l4 = lp[q]; z += l4.x * wa[4 * q] + l4.y * wa[4 * q + 1] + l4.z * wa[4 * q + 2] + l4.w * wa[4 * q + 3]; }
            const float ls = fminf(z, 0.f) - __logf(1.0f + __expf(-fabsf(z)));
            run += ls * 0.0625f; la[jj] = run;
        }
        TOT[w * 64 + k] = run;
        __syncthreads();
        float off = 0.f;
#pragma unroll
        for (int w2 = 0; w2 < 7; ++w2) off += (w2 < w) ? TOT[w2 * 64 + k] : 0.f;
#pragma unroll
        for (int jj = 0; jj < 8; ++jj) BS[(8 * w + jj) * 65 + k] = la[jj] + off;
    } else {
        const float lg = __logf(1.0f - exp2f(-5.0f - (float)I.h));
#pragma unroll
        for (int jj = 0; jj < 8; ++jj) BS[(8 * w + jj) * 65 + k] = (float)(8 * w + jj + 1) * lg;
    }
    __syncthreads();
}
__device__ __forceinline__ void load_qk8(const bf16* p, float (&lo)[4], float (&hi)[4]) {
    const v2u x = *(const v2u*)p, y = *(const v2u*)(p + 32);
    lo[0] = bflo(x.x); lo[1] = bfhi(x.x); lo[2] = bflo(x.y); lo[3] = bfhi(x.y);
    hi[0] = bflo(y.x); hi[1] = bfhi(y.x); hi[2] = bflo(y.y); hi[3] = bfhi(y.y);
}
__device__ __forceinline__ void rotary8(const float* tabp, float (&lo)[4], float (&hi)[4]) {
    const f32x4 t0 = ((const f32x4*)tabp)[0], t1 = ((const f32x4*)tabp)[1];
    const float c[4] = {t0.x, t0.z, t1.x, t1.z}, s[4] = {t0.y, t0.w, t1.y, t1.w};
#pragma unroll
    for (int e = 0; e < 4; ++e) { const float a = lo[e], b = hi[e]; lo[e] = a * c[e] - b * s[e]; hi[e] = a * s[e] + b * c[e]; }
}
__device__ __forceinline__ int swz_off(int row, int col) { return row * PB + ((((col >> 3) ^ (row >> 3)) & 7) << 4) + (col & 7) * 2; }
__device__ __forceinline__ void stage_vt(LAS unsigned char* lds, const UnitInfo& I, const bf16* proj, int tid) {
    const int c = tid & 15;
#pragma unroll
    for (int p = 0; p < 2; ++p) {
        const int j = (tid >> 4) + 32 * p;
        const v4u x = *(const v4u*)(proj + (I.m0 + j) * LDP + I.vcol + 8 * c);
        const unsigned xs[4] = {x.x, x.y, x.z, x.w};
#pragma unroll
        for (int e = 0; e < 8; ++e) { const unsigned short val = (unsigned short)((xs[e >> 1] >> (16 * (e & 1))) & 0xffffu);
            *(LAS unsigned short*)(lds + L_VT + swz_off(8 * c + e, j)) = val; }
    }
}
__device__ __forceinline__ bf16x8 frag_plain(LAS unsigned char* base, int t16, int kk, int lane) { const int row = 16 * t16 + (lane & 15); return *(const LAS bf16x8*)(base + row * PB + (32 * kk + 8 * (lane >> 4)) * 2); }
__device__ __forceinline__ bf16x8 frag_swz(LAS unsigned char* base, int t16, int kk, int lane) { const int row = 16 * t16 + (lane & 15); const int jc = 4 * kk + (lane >> 4); return *(const LAS bf16x8*)(base + row * PB + (((jc ^ (row >> 3)) & 7) << 4)); }
#define MFMA16(X, Y, C) __builtin_amdgcn_mfma_f32_16x16x32_bf16((X), (Y), (C), 0, 0, 0)

__device__ __forceinline__ void attn_pass_a(LAS unsigned char* lds, int u, const bf16* proj, const float* tab, const float* w_a2, const float* b_a, float* KV, float* DEC, int tid) {
    const UnitInfo I = unit_info(u); const int lane = tid & 63, w = tid >> 6;
    LAS float* BS = (LAS float*)(lds + L_BS);
    attn_compute_b(lds, I, proj, w_a2, b_a, tid);
    {
        const int j = tid >> 3, g = tid & 7;
        float klo[4], khi[4];
        load_qk8(proj + (I.m0 + j) * LDP + I.kcol + 4 * g, klo, khi);
        if (!I.gla) { rotary8(tab + ((size_t)(I.n * CH + j) * 32 + 4 * g) * 2, klo, khi);
#pragma unroll
            for (int e = 0; e < 4; ++e) { klo[e] *= 0.125f; khi[e] *= 0.125f; } }
#pragma unroll
        for (int e = 0; e < 4; ++e) {
            const int c0 = 4 * g + e, c1 = c0 + 32;
            const float d0 = __expf(BS[63 * 65 + c0] - BS[j * 65 + c0]), d1 = __expf(BS[63 * 65 + c1] - BS[j * 65 + c1]);
            *(LAS unsigned short*)(lds + L_KDT + swz_off(c0, j)) = (unsigned short)(pk2(klo[e] * d0, 0.f) & 0xffffu);
            *(LAS unsigned short*)(lds + L_KDT + swz_off(c1, j)) = (unsigned short)(pk2(khi[e] * d1, 0.f) & 0xffffu);
        }
        if (tid < 64) DEC[(size_t)u * 64 + tid] = __expf(BS[63 * 65 + tid]);
    }
    stage_vt(lds, I, proj, tid);
    __syncthreads();
    {
        const int vt = w; float* KVu = KV + (size_t)u * 8192;
#pragma unroll
        for (int kt = 0; kt < 4; ++kt) {
            f32x4 acc = {0.f, 0.f, 0.f, 0.f};
#pragma unroll
            for (int kk = 0; kk < 2; ++kk) acc = MFMA16(frag_swz(lds + L_VT, vt, kk, lane), frag_swz(lds + L_KDT, kt, kk, lane), acc);
            const int v0 = 16 * vt + 4 * (lane >> 4), k = 16 * kt + (lane & 15);
#pragma unroll
            for (int e = 0; e < 4; ++e) KVu[(v0 + e) * 64 + k] = acc[e];
        }
    }
}
__device__ __forceinline__ void attn_pass_c(LAS unsigned char* lds, int u, const bf16* proj, const float* tab, const float* w_a2, const float* b_a, const bf16* ST, const float* ng_ret, const float* ng_gla, bf16* O, int tid) {
    const UnitInfo I = unit_info(u); const int lane = tid & 63, w = tid >> 6;
    LAS float* BS = (LAS float*)(lds + L_BS); LAS float* RED = (LAS float*)(lds + L_RED);
    attn_compute_b(lds, I, proj, w_a2, b_a, tid);
    {
        const int j = tid >> 3, g = tid & 7;
        float qlo[4], qhi[4], klo[4], khi[4];
        load_qk8(proj + (I.m0 + j) * LDP + I.qcol + 4 * g, qlo, qhi);
        load_qk8(proj + (I.m0 + j) * LDP + I.kcol + 4 * g, klo, khi);
        if (!I.gla) { const float* tp = tab + ((size_t)(I.n * CH + j) * 32 + 4 * g) * 2; rotary8(tp, qlo, qhi); rotary8(tp, klo, khi);
#pragma unroll
            for (int e = 0; e < 4; ++e) { klo[e] *= 0.125f; khi[e] *= 0.125f; } }
        else {
#pragma unroll
            for (int e = 0; e < 4; ++e) { qlo[e] *= 0.125f; qhi[e] *= 0.125f; } }
        float qp[8], qm[8], kp[8], km[8], qe[8];
#pragma unroll
        for (int e = 0; e < 4; ++e) {
            const int c0 = 4 * g + e, c1 = c0 + 32;
            const float b0 = BS[j * 65 + c0], b1 = BS[j * 65 + c1], r0 = BS[32 * 65 + c0], r1 = BS[32 * 65 + c1];
            const float p0 = __expf(b0 - r0), m0 = __expf(r0 - b0), p1 = __expf(b1 - r1), m1 = __expf(r1 - b1), e0 = __expf(b0), e1 = __expf(b1);
            qp[e] = qlo[e] * p0; qm[e] = qlo[e] * m0; kp[e] = klo[e] * p0; km[e] = klo[e] * m0; qe[e] = qlo[e] * e0;
            qp[4 + e] = qhi[e] * p1; qm[4 + e] = qhi[e] * m1; kp[4 + e] = khi[e] * p1; km[4 + e] = khi[e] * m1; qe[4 + e] = qhi[e] * e1;
        }
        const int o0 = j * PB + 8 * g, o1 = o0 + 64;
#define ST8(OFF, A) do { *(LAS v2u*)(lds + (OFF) + o0) = (v2u){pk2(A[0], A[1]), pk2(A[2], A[3])}; *(LAS v2u*)(lds + (OFF) + o1) = (v2u){pk2(A[4], A[5]), pk2(A[6], A[7])}; } while (0)
        ST8(L_QP, qp); ST8(L_QM, qm); ST8(L_KP, kp); ST8(L_KM, km); ST8(L_QE, qe);
#undef ST8
    }
    stage_vt(lds, I, proj, tid);
    __syncthreads();
    {
        const int jt = w & 3;
#pragma unroll
        for (int ii = 0; ii < 2; ++ii) {
            const int it = (w >> 2) * 2 + ii;
            f32x4 lo = {0.f, 0.f, 0.f, 0.f}, hi = {0.f, 0.f, 0.f, 0.f};
#pragma unroll
            for (int kk = 0; kk < 2; ++kk) { lo = MFMA16(frag_plain(lds + L_KM, jt, kk, lane), frag_plain(lds + L_QP, it, kk, lane), lo);
                                             hi = MFMA16(frag_plain(lds + L_KP, jt, kk, lane), frag_plain(lds + L_QM, it, kk, lane), hi); }
            const int i = 16 * it + (lane & 15), j0 = 16 * jt + 4 * (lane >> 4);
            float s[4];
#pragma unroll
            for (int e = 0; e < 4; ++e) s[e] = (j0 + e <= i) ? lo[e] : hi[e];
            *(LAS v2u*)(lds + L_PS + i * PB + j0 * 2) = (v2u){pk2(s[0], s[1]), pk2(s[2], s[3])};
        }
    }
    __syncthreads();
    {
        const int it = w & 3, vh = w >> 2; const bf16* STu = ST + (size_t)u * 8192;
        f32x4 acc[4];
#pragma unroll
        for (int a = 0; a < 4; ++a) acc[a] = (f32x4){0.f, 0.f, 0.f, 0.f};
#pragma unroll
        for (int kk = 0; kk < 2; ++kk) {
            const bf16x8 y1 = frag_plain(lds + L_PS, it, kk, lane), y2 = frag_plain(lds + L_QE, it, kk, lane);
#pragma unroll
            for (int a = 0; a < 4; ++a) { const int vt = 4 * vh + a;
                const bf16x8 x2 = *(const bf16x8*)(STu + (16 * vt + (lane & 15)) * 64 + 32 * kk + 8 * (lane >> 4));
                acc[a] = MFMA16(frag_swz(lds + L_VT, vt, kk, lane), y1, acc[a]);
                acc[a] = MFMA16(x2, y2, acc[a]); }
        }
        float ss = 0.f;
#pragma unroll
        for (int a = 0; a < 4; ++a) ss += (acc[a].x * acc[a].x + acc[a].y * acc[a].y) + (acc[a].z * acc[a].z + acc[a].w * acc[a].w);
        ss += __shfl_xor(ss, 16); ss += __shfl_xor(ss, 32);
        const int i = 16 * it + (lane & 15);
        if ((lane >> 4) == 0) RED[i * 2 + vh] = ss;
        __syncthreads();
        const float r = 1.0f / sqrtf((RED[i * 2] + RED[i * 2 + 1]) * (1.f / 128.f) + RMS_EPS);
        const float* ng = (I.gla ? ng_gla : ng_ret) + 128 * I.h;
        const bf16* grow = proj + (I.m0 + i) * LDP + I.gcol; bf16* orow = O + (I.m0 + i) * D + I.ocol;
#pragma unroll
        for (int a = 0; a < 4; ++a) { const int v0 = 16 * (4 * vh + a) + 4 * (lane >> 4);
            const v2u gv = *(const v2u*)(grow + v0); const f32x4 g4 = *(const f32x4*)(ng + v0);
            const float o0 = acc[a].x * r * g4.x * silu_f(bflo(gv.x)), o1 = acc[a].y * r * g4.y * silu_f(bfhi(gv.x)), o2 = acc[a].z * r * g4.z * silu_f(bflo(gv.y)), o3 = acc[a].w * r * g4.w * silu_f(bfhi(gv.y));
            *(v2u*)(orow + v0) = (v2u){pk2(o0, o1), pk2(o2, o3)}; }
    }
}

struct Args { const float* in[17]; float* out; unsigned char* ws; int ph_lo, ph_hi; };
constexpr int N_PHASES = 13;
__global__ void __launch_bounds__(NTHR, 2) fwd_kernel(Args a) {
    extern __shared__ __attribute__((aligned(16))) unsigned char lds_raw[];
    LAS unsigned char* lds = (LAS unsigned char*)lds_raw;
    cg::grid_group grid = cg::this_grid();
    const int tid = threadIdx.x, lane = tid & 63, wave = __builtin_amdgcn_readfirstlane(tid >> 6);
    const int G = gridDim.x, bx = blockIdx.x;
    const int gw = bx * NWAVES + wave, NGW = G * NWAVES;
    const long gt = (long)bx * NTHR + tid, NGT = (long)G * NTHR;
    unsigned char* ws = a.ws;
    const float* x = a.in[0];
    const float *ffn1_g = a.in[1], *ffn1_wg = a.in[2], *ffn1_wu = a.in[3], *ffn1_wd = a.in[4], *mix_g = a.in[5], *w_in = a.in[6], *ret_ng = a.in[7], *w_a2 = a.in[8], *b_a = a.in[9],
                *gla_ng = a.in[10], *w_out = a.in[11], *ffn2_g = a.in[12], *ffn2_wg = a.in[13], *ffn2_wu = a.in[14], *ffn2_wd = a.in[15], *fin_g = a.in[16];
    float* out = a.out;
    bf16 *Wgu1 = (bf16*)(ws + WS_WGU1), *Wd1 = (bf16*)(ws + WS_WD1), *Win = (bf16*)(ws + WS_WIN), *Wout = (bf16*)(ws + WS_WOUT), *Wgu2 = (bf16*)(ws + WS_WGU2), *Wd2 = (bf16*)(ws + WS_WD2);
    float* TAB = (float*)(ws + WS_TAB); float* DEC = (float*)(ws + WS_DEC); bf16* H = (bf16*)(ws + WS_H); bf16* STb = (bf16*)(ws + WS_ST);
    bf16* PROJ = (bf16*)(ws + WS_PROJ); bf16* ACT = (bf16*)(ws + WS_ACT); float* KV = (float*)(ws + WS_KV); bf16* Ob = (bf16*)(ws + WS_O);
    const int lo = a.ph_lo, hi = a.ph_hi;
    if (tid < 16) ((LAS unsigned*)(lds + 131072))[tid + 0] = 0u;
    if (tid < 32) ((LAS unsigned*)(lds + 131072))[tid + 16] = 0u;
    __syncthreads();
    XcdBarrier bar = xcd_barrier_post((unsigned*)(ws + WS_CTL), (volatile LAS unsigned*)(lds + MISC_OFF));
    if (hi > 1000) grid.sync();
#define IN(k) (lo <= (k) && (k) < hi)
#define SEAM(k) do { if (IN(k) && IN((k) + 1)) xcd_barrier(bar); } while (0)

    if (IN(0)) {
        LAS float* scr = (LAS float*)(lds + wave * 16384);
        constexpr int I_G = (D / 64) * (FF / 32), I_D = (FF / 64) * (D / 32), I_IN = (D / 64) * 97, I_O = (D / 64) * (D / 32);
        constexpr int NITEMS = 6 * I_G + I_IN + I_O;
        static_assert(I_G == I_D, "items");
        for (int it = gw; it < NITEMS; it += NGW) {
            int r = it;
            if (r < I_G) { transpose_item(ffn1_wg, D, FF, Wgu1, FF / 32, 1, scr, r, lane); continue; } r -= I_G;
            if (r < I_G) { transpose_item(ffn1_wu, D, FF, Wgu1, FF / 32, 2, scr, r, lane); continue; } r -= I_G;
            if (r < I_D) { transpose_item(ffn1_wd, FF, D, Wd1, D / 32, 0, scr, r, lane); continue; } r -= I_D;
            if (r < I_G) { transpose_item(ffn2_wg, D, FF, Wgu2, FF / 32, 1, scr, r, lane); continue; } r -= I_G;
            if (r < I_G) { transpose_item(ffn2_wu, D, FF, Wgu2, FF / 32, 2, scr, r, lane); continue; } r -= I_G;
            if (r < I_D) { transpose_item(ffn2_wd, FF, D, Wd2, D / 32, 0, scr, r, lane); continue; } r -= I_D;
            if (r < I_IN) { transpose_item(w_in, D, INW, Win, 97, 0, scr, r, lane); continue; } r -= I_IN;
            transpose_item(w_out, D, D, Wout, D / 32, 0, scr, r, lane);
        }
        { v4u* z = (v4u*)(Win + (size_t)3104 * D); const long nz = (long)(LDP - 3104) * D * 2 / 16; for (long i = gt; i < nz; i += NGT) z[i] = (v4u){0u, 0u, 0u, 0u}; }
        for (long i = gt; i < (long)T * 32; i += NGT) { const int pos = (int)(i >> 5), f = (int)(i & 31);
            const float inv = powf(10000.0f, -(float)f * (1.0f / 32.0f)); const float ang = (float)pos * inv;
            *(f32x2v*)(TAB + 2 * i) = (f32x2v){cosf(ang), sinf(ang)}; }
        for (int m = gw; m < M; m += NGW) norm_row_bf16(x + (size_t)m * D, ffn1_g, H + (size_t)m * D, lane);
    }
    SEAM(0);
    if (IN(1)) { pg8::Gemm g{H, Wgu1, M, NGU, D}; pg8::StaticOrder S; S.init(M, NGU, G, bx); EpiSwiGLU E{ACT, FF};
        pg8::gemm_phase<EpiSwiGLU, pg8::StaticOrder, PG8_ALIGN, PG8_SP2>(lds, g, S, E); }
    SEAM(1);
    if (IN(2)) { pg8::Gemm g{ACT, Wd1, M, D, FF}; pg8::StaticOrder S; S.init(M, D, G, bx); EpiResid E{x, out, D, 0.5f};
        pg8::gemm_phase<EpiResid, pg8::StaticOrder, PG8_ALIGN, PG8_SP2>(lds, g, S, E); }
    SEAM(2);
    if (IN(3)) { for (int m = gw; m < M; m += NGW) norm_row_bf16(out + (size_t)m * D, mix_g, H + (size_t)m * D, lane); }
    SEAM(3);
    if (IN(4)) { pg8::Gemm g{H, Win, M, LDP, D}; pg8::StaticOrder S; S.init(M, LDP, G, bx); pg8::EpiBf16<0> E{PROJ, LDP, nullptr, 0, 0, 1.f};
        pg8::gemm_phase<pg8::EpiBf16<0>, pg8::StaticOrder, PG8_ALIGN, PG8_SP2>(lds, g, S, E); }
    SEAM(4);
    if (IN(5)) { for (int u = bx; u < NUNITS; u += G) attn_pass_a(lds, u, PROJ, TAB, w_a2, b_a, KV, DEC, tid); }
    SEAM(5);
    if (IN(6)) {
        for (long e2 = gt; e2 < (long)BATCH * 8 * 4096; e2 += NGT) {
            const int bh = (int)(e2 >> 12), el = (int)(e2 & 4095) * 2, k = el & 63;
            float r0 = 0.f, r1 = 0.f;
            for (int n0 = 0; n0 < NCH; n0 += 8) {
                f32x2v kv[8], dc[8];
#pragma unroll
                for (int q = 0; q < 8; ++q) { const size_t uu = (size_t)bh * 64 + n0 + q; kv[q] = *(const f32x2v*)(KV + uu * 8192 + el); dc[q] = *(const f32x2v*)(DEC + uu * 64 + k); }
#pragma unroll
                for (int q = 0; q < 8; ++q) { const size_t uu = (size_t)bh * 64 + n0 + q; *(unsigned*)(STb + uu * 8192 + el) = pk2(r0, r1); r0 = dc[q].x * r0 + kv[q].x; r1 = dc[q].y * r1 + kv[q].y; }
            }
        }
    }
    SEAM(6);
    if (IN(7)) { for (int u = bx; u < NUNITS; u += G) attn_pass_c(lds, u, PROJ, TAB, w_a2, b_a, STb, ret_ng, gla_ng, Ob, tid); }
    SEAM(7);
    if (IN(8)) { pg8::Gemm g{Ob, Wout, M, D, D}; pg8::StaticOrder S; S.init(M, D, G, bx); EpiResid E{out, out, D, 1.0f};
        pg8::gemm_phase<EpiResid, pg8::StaticOrder, PG8_ALIGN, PG8_SP2>(lds, g, S, E); }
    SEAM(8);
    if (IN(9)) { for (int m = gw; m < M; m += NGW) norm_row_bf16(out + (size_t)m * D, ffn2_g, H + (size_t)m * D, lane); }
    SEAM(9);
    if (IN(10)) { pg8::Gemm g{H, Wgu2, M, NGU, D}; pg8::StaticOrder S; S.init(M, NGU, G, bx); EpiSwiGLU E{ACT, FF};
        pg8::gemm_phase<EpiSwiGLU, pg8::StaticOrder, PG8_ALIGN, PG8_SP2>(lds, g, S, E); }
    SEAM(10);
    if (IN(11)) { pg8::Gemm g{ACT, Wd2, M, D, FF}; pg8::StaticOrder S; S.init(M, D, G, bx); EpiResid E{out, out, D, 0.5f};
        pg8::gemm_phase<EpiResid, pg8::StaticOrder, PG8_ALIGN, PG8_SP2>(lds, g, S, E); }
    SEAM(11);
    if (IN(12)) { for (int m = gw; m < M; m += NGW) norm_row_f32(out + (size_t)m * D, fin_g, lane); }
#undef IN
#undef SEAM
}

#ifndef MK_N_LAUNCHES
#define MK_N_LAUNCHES 1
#endif
extern "C" void kernel_launch(void* const* d_in, const int* in_sizes, int n_in, void* d_out, int out_size, void* d_ws, size_t ws_size, hipStream_t stream) {
    static int grid = 0;
    if (grid == 0) {
        if (n_in != 17 || in_sizes[0] != M * D || out_size != M * D || ws_size < WS_END) { fprintf(stderr, "kernel_launch: unexpected shapes (n_in %d, in0 %d, out %d, ws %zu)\n", n_in, n_in > 0 ? in_sizes[0] : -1, out_size, ws_size); grid = -1; return; }
        int dev = 0, cus = 0, per_cu = 0;
        if (hipGetDevice(&dev) != hipSuccess || hipDeviceGetAttribute(&cus, hipDeviceAttributeMultiprocessorCount, dev) != hipSuccess) { grid = -1; return; }
        if (hipFuncSetAttribute((const void*)fwd_kernel, hipFuncAttributeMaxDynamicSharedMemorySize, LDS_BYTES) != hipSuccess) { fprintf(stderr, "kernel_launch: hipFuncSetAttribute failed\n"); grid = -1; return; }
        if (hipOccupancyMaxActiveBlocksPerMultiprocessor(&per_cu, (const void*)fwd_kernel, NTHR, LDS_BYTES) != hipSuccess || per_cu < 1) { fprintf(stderr, "kernel_launch: occupancy query says %d\n", per_cu); per_cu = 1; }
        (void)hipGetLastError();
        grid = cus * per_cu;
    }
    if (grid < 0) return;
    if (hipMemsetAsync((char*)d_ws + WS_CTL, 0, CTL_BYTES, stream) != hipSuccess) { fprintf(stderr, "kernel_launch: memset failed\n"); return; }
    Args a{};
    for (int i = 0; i < 17; ++i) a.in[i] = (const float*)d_in[i];
    a.out = (float*)d_out; a.ws = (unsigned char*)d_ws;
#if MK_N_LAUNCHES == 1
    a.ph_lo = 0; a.ph_hi = N_PHASES;
    void* args[] = {&a};
    hipError_t e = hipLaunchCooperativeKernel((const void*)fwd_kernel, dim3(grid), dim3(NTHR), args, LDS_BYTES, stream);
    if (e != hipSuccess) fprintf(stderr, "cooperative launch failed: %s (grid %d)\n", hipGetErrorString(e), grid);
#else
    for (int p = 0; p < N_PHASES; ++p) { a.ph_lo = p; a.ph_hi = p + 1; hipLaunchKernelGGL(fwd_kernel, dim3(grid), dim3(NTHR), LDS_BYTES, stream, a); }
#endif
}
```

```cpp
#include <hip/hip_runtime.h>
#include <cstdio>
#include <cstdint>
#include <hip/hip_cooperative_groups.h>
namespace pg8 {
#define PG8_LAS __attribute__((address_space(3)))
typedef unsigned short bf16_t;
typedef short bf16x8 __attribute__((ext_vector_type(8)));
typedef float f32x4 __attribute__((ext_vector_type(4)));
typedef unsigned u32x4 __attribute__((ext_vector_type(4)));
constexpr int BM = 256, BK = 64, HALF = 128, HTB = HALF * BK * 2  , STAGE_BYTES = 8 * HTB, NXCD = 8, WGM = 8;

__host__ __device__ __forceinline__ int lds_byte(int r, int c) { const int st = (r >> 4) * 2 + (c >> 5), rr = r & 15, cc = c & 31, ob = rr * 64 + cc * 2; return st * 1024 + (ob ^ (((ob >> 9) & 1) << 5)); }
__host__ __device__ __forceinline__ void stage_rc(int b, int& R, int& C) { const int st = b / 1024, sb = b % 1024, swz = sb ^ (((sb >> 9) & 1) << 5); R = (st >> 1) * 16 + swz / 64; C = (st & 1) * 32 + (swz % 64) / 2; }
__host__ __device__ __forceinline__ int perm32(int rho) { const int n = rho >> 4, i = rho & 15; return 8 * (i >> 2) + 4 * n + (i & 3); }

struct Unit { int pm, pn, ord; };
struct Gemm { const bf16_t* A; const bf16_t* Bt; int M, N, K; };

struct StaticOrder {
    int nM, nN, nwg, G, c;
    __host__ __device__ void init(int M, int N, int G_, int c_) { nM = M / BM; nN = N / BM; nwg = nM * nN; G = G_; c = c_; }
    __host__ __device__ bool next(int i, Unit& u) const {
        const long L = (long)i * G + c; if (L >= nwg) return false;
        int wgid = (int)L; { const int q = nwg / NXCD, r = nwg % NXCD, xcd = wgid % NXCD, off = wgid / NXCD; wgid = (xcd < r ? xcd * (q + 1) : r * (q + 1) + (xcd - r) * q) + off; }
        const int nig = WGM * nN, gid = wgid / nig, fm = gid * WGM, gsz = (nM - fm) < WGM ? (nM - fm) : WGM;
        u.pm = fm + ((wgid % nig) % gsz); u.pn = (wgid % nig) / gsz; u.ord = i; return true;
    }
    __device__ __forceinline__ void a_ready(const Unit&) const {}
    __device__ __forceinline__ void done(const Unit&) const {}
};

__device__ __forceinline__ unsigned cvt_pk_bf16(float lo, float hi) { unsigned r; asm volatile("v_cvt_pk_bf16_f32 %0, %1, %2" : "=v"(r) : "v"(lo), "v"(hi)); return r; }
typedef float f32x2 __attribute__((ext_vector_type(2)));
__device__ __forceinline__ f32x2 gelu_pk(f32x2 v) {
    const f32x2 av = __builtin_elementwise_abs(v), d = av * 0.2316418882f + 1.0f;
    f32x2 t; t.x = __builtin_amdgcn_rcpf(d.x); t.y = __builtin_amdgcn_rcpf(d.y);
    f32x2 q = t * 0.5307027145f + (-0.7265760135f); q = q * t + 0.7107068705f; q = q * t + (-0.142248368f); q = q * t + 0.127414796f; q = q * t;
    const f32x2 s = (v * v) * (-0.72134752044f);
    f32x2 e; e.x = __builtin_amdgcn_exp2f(s.x); e.y = __builtin_amdgcn_exp2f(s.y);
    const f32x2 m = v * (q * e), r = v - m;
    f32x2 o; o.x = v.x < 0.f ? m.x : r.x; o.y = v.y < 0.f ? m.y : r.y; return o;
}

template <int ACT  > struct EpiBf16 {
    static constexpr bool PERM = true, AFTER_DRAIN = false; static_assert(ACT == 0 || ACT == 1, "EpiBf16: ACT is 0 (none) or 1 (gelu_pk)");
    bf16_t* O; int ldc; const float* bias; int split_cols; size_t split_stride; float scale0;
    __device__ __forceinline__ void operator()(const f32x4 (&acc)[2][2][4][2], const Unit& u, int wr, int wc, int fr, int fq) const {
        const int row0 = u.pm * BM + wr * 64 + fr; int colt = u.pn * BM; bf16_t* base = O;
        float sc = 1.f; if (split_cols) { const int t = colt / split_cols; base += (size_t)t * split_stride; colt -= t * split_cols; if (t == 0) sc = scale0; }
        const int col0 = colt + wc * 32 + 8 * fq, bcol0 = u.pn * BM + wc * 32 + 8 * fq;
        f32x4 bv[2][2];
#pragma unroll
        for (int bj = 0; bj < 2; ++bj)
#pragma unroll
            for (int n = 0; n < 2; ++n) bv[bj][n] = bias ? *(const f32x4*)(bias + bcol0 + bj * HALF + 4 * n) : (f32x4){0.f, 0.f, 0.f, 0.f};
#pragma unroll
        for (int ai = 0; ai < 2; ++ai)
#pragma unroll
            for (int m = 0; m < 4; ++m) { bf16_t* rowp = base + (size_t)(row0 + ai * HALF + m * 16) * ldc + col0;
#pragma unroll
                for (int bj = 0; bj < 2; ++bj) { f32x4 v0 = acc[ai][bj][m][0] + bv[bj][0], v1 = acc[ai][bj][m][1] + bv[bj][1];
                    if (ACT == 1) { f32x2 a = gelu_pk((f32x2){v0[0], v0[1]}), b = gelu_pk((f32x2){v0[2], v0[3]}), c = gelu_pk((f32x2){v1[0], v1[1]}), d = gelu_pk((f32x2){v1[2], v1[3]});
                        v0 = (f32x4){a.x, a.y, b.x, b.y}; v1 = (f32x4){c.x, c.y, d.x, d.y}; }
                    v0 = v0 * sc; v1 = v1 * sc; u32x4 w; w.x = cvt_pk_bf16(v0[0], v0[1]); w.y = cvt_pk_bf16(v0[2], v0[3]); w.z = cvt_pk_bf16(v1[0], v1[1]); w.w = cvt_pk_bf16(v1[2], v1[3]);
                    *(u32x4*)(rowp + bj * HALF) = w; } }
    }
};
template <class Epi, class Sched, bool ALIGN_EPI = false, bool SP2 = false>
__device__ __forceinline__ void gemm_phase(PG8_LAS unsigned char* lds, const Gemm g, const Sched S, const Epi E) {
    const int tid = threadIdx.x, wid = __builtin_amdgcn_readfirstlane(tid >> 6), lane = tid & 63, wr = wid >> 2, wc = wid & 3, fr = lane & 15, fq = lane >> 4;
    const int K = g.K, nt = K / BK;
    unsigned voffA[2], voffB[2];
#pragma unroll
    for (int i = 0; i < 2; ++i) { int R, C; stage_rc(tid * 16 + i * 8192, R, C); const int Rb = Epi::PERM ? ((R & ~31) + perm32(R & 31)) : R;
        voffA[i] = (unsigned)(R * K + C) * 2u; voffB[i] = (unsigned)(Rb * K + C) * 2u; }
    const size_t kstep = (size_t)(BK * 2);
    const size_t hstep = (size_t)HALF * K * 2;
    const size_t tstep = 2 * hstep;
    const unsigned ldsw = (unsigned)wid * 1024u;
    const int aoff = lds_byte(wr * 64 + fr, fq * 8), boff = lds_byte(wc * 32 + fr, fq * 8);
#define PG8_SA(b, h) (((b) * 2 + (h)) * HTB)
#define PG8_SB(b, h) ((4 + (b) * 2 + (h)) * HTB)
#define PG8_STAGE(bufoff, gbase, voff) do { _Pragma("unroll") for (int _i = 0; _i < 2; ++_i) \
        __builtin_amdgcn_global_load_lds((const unsigned*)((const char*)(gbase) + (voff)[_i]), (PG8_LAS unsigned*)(lds + (bufoff) + ldsw + _i * 8192), 16, 0, 0); } while (0)
#define PG8_LDA(dst, b, h) do { _Pragma("unroll") for (int m = 0; m < 4; ++m) _Pragma("unroll") for (int k = 0; k < 2; ++k) dst[m][k] = *(const PG8_LAS bf16x8*)(lds + PG8_SA(b, h) + aoff + m * 2048 + k * 1024); } while (0)
#define PG8_LDB(dst, b, h) do { _Pragma("unroll") for (int n = 0; n < 2; ++n) _Pragma("unroll") for (int k = 0; k < 2; ++k) dst[n][k] = *(const PG8_LAS bf16x8*)(lds + PG8_SB(b, h) + boff + n * 2048 + k * 1024); } while (0)
#define PG8_MMA(ai, bj, At, Bt) do { __builtin_amdgcn_s_setprio(1); _Pragma("unroll") for (int m = 0; m < 4; ++m) _Pragma("unroll") for (int n = 0; n < 2; ++n) _Pragma("unroll") for (int k = 0; k < 2; ++k) \
        acc[ai][bj][m][n] = __builtin_amdgcn_mfma_f32_16x16x32_bf16(Bt[n][k], At[m][k], acc[ai][bj][m][n], 0, 0, 0); __builtin_amdgcn_s_setprio(0); } while (0)
#define PG8_WAIT_V(n) asm volatile("s_waitcnt vmcnt(" #n ")" ::: "memory")
#define PG8_WAIT_L(n) asm volatile("s_waitcnt lgkmcnt(" #n ")" ::: "memory")
#define PG8_BAR __builtin_amdgcn_s_barrier()
#define PG8_SCHED __builtin_amdgcn_sched_barrier(0)
    Unit cur, nxt; int ui = 0;
    if (!S.next(0, cur)) return;
    f32x4 acc[2][2][4][2];
#pragma unroll
    for (int a = 0; a < 2; ++a)
#pragma unroll
        for (int b = 0; b < 2; ++b)
#pragma unroll
            for (int m = 0; m < 4; ++m)
#pragma unroll
                for (int n = 0; n < 2; ++n) acc[a][b][m][n] = (f32x4){0.f, 0.f, 0.f, 0.f};
    bf16x8 At[4][2], B0[2][2], B1[2][2];
    const char* cA = (const char*)g.A + (size_t)cur.pm * tstep; const char* cB = (const char*)g.Bt + (size_t)cur.pn * tstep;
    S.a_ready(cur);
    if constexpr (SP2) {
        PG8_STAGE(PG8_SB(0, 0), cB, voffB); PG8_STAGE(PG8_SB(0, 1), cB + hstep, voffB); PG8_STAGE(PG8_SA(0, 0), cA, voffA); PG8_STAGE(PG8_SA(0, 1), cA + hstep, voffA);
        if (wr == 1) PG8_BAR;
        PG8_WAIT_V(2); PG8_BAR;
        PG8_STAGE(PG8_SB(1, 0), cB + kstep, voffB); PG8_STAGE(PG8_SA(1, 0), cA + kstep, voffA); PG8_STAGE(PG8_SB(1, 1), cB + hstep + kstep, voffB);
        PG8_WAIT_V(6); PG8_BAR;
    } else {
        PG8_STAGE(PG8_SB(0, 0), cB, voffB); PG8_STAGE(PG8_SA(0, 0), cA, voffA); PG8_STAGE(PG8_SB(0, 1), cB + hstep, voffB); PG8_STAGE(PG8_SA(0, 1), cA + hstep, voffA);
        if (wr == 1) PG8_BAR;
        PG8_WAIT_V(4); PG8_BAR;
        PG8_STAGE(PG8_SB(1, 0), cB + kstep, voffB); PG8_STAGE(PG8_SA(1, 0), cA + kstep, voffA); PG8_STAGE(PG8_SB(1, 1), cB + hstep + kstep, voffB);
        PG8_WAIT_V(6); PG8_BAR;
    }
    for (;;) {
        const bool has_next = S.next(ui + 1, nxt);
        const char* nA = has_next ? (const char*)g.A + (size_t)nxt.pm * tstep : cA; const char* nB = has_next ? (const char*)g.Bt + (size_t)nxt.pn * tstep : cB;
        for (int t = 0; t < nt; t += 2) {
            const bool last = (t == nt - 2);
            const char* a1 = cA + (size_t)(t + 1) * kstep;
            const char* a2 = last ? nA : cA + (size_t)(t + 2) * kstep; const char* b2 = last ? nB : cB + (size_t)(t + 2) * kstep;
            const char* a3 = a2 + kstep; const char* b3 = b2 + kstep;
            if (last && has_next) S.a_ready(nxt);
            if constexpr (SP2) {
            PG8_LDB(B0, 0, 0); PG8_LDB(B1, 0, 1); PG8_SCHED; PG8_LDA(At, 0, 0); PG8_STAGE(PG8_SA(1, 1), a1 + hstep, voffA);
            PG8_WAIT_V(8); PG8_WAIT_L(0); PG8_BAR; PG8_MMA(0, 0, At, B0); PG8_MMA(0, 1, At, B1); PG8_BAR; PG8_SCHED;
            PG8_LDA(At, 0, 1); PG8_STAGE(PG8_SB(0, 0), b2, voffB); PG8_STAGE(PG8_SB(0, 1), b2 + hstep, voffB); PG8_STAGE(PG8_SA(0, 0), a2, voffA);
            PG8_WAIT_V(8); PG8_WAIT_L(0); PG8_BAR; PG8_MMA(1, 0, At, B0); PG8_MMA(1, 1, At, B1); PG8_BAR; PG8_SCHED;
            PG8_LDB(B0, 1, 0); PG8_LDB(B1, 1, 1); PG8_SCHED; PG8_LDA(At, 1, 0); PG8_STAGE(PG8_SA(0, 1), a2 + hstep, voffA);
            PG8_WAIT_V(8); PG8_WAIT_L(0); PG8_BAR; PG8_MMA(0, 0, At, B0); PG8_MMA(0, 1, At, B1); PG8_BAR; PG8_SCHED;
            PG8_LDA(At, 1, 1); PG8_STAGE(PG8_SB(1, 0), b3, voffB); PG8_STAGE(PG8_SB(1, 1), b3 + hstep, voffB); PG8_STAGE(PG8_SA(1, 0), a3, voffA);
            PG8_WAIT_V(8); PG8_WAIT_L(0); PG8_BAR; PG8_MMA(1, 0, At, B0); PG8_MMA(1, 1, At, B1); PG8_BAR; PG8_SCHED;
            } else {
            PG8_LDB(B0, 0, 0); PG8_SCHED; PG8_LDA(At, 0, 0); PG8_STAGE(PG8_SA(1, 1), a1 + hstep, voffA);
            PG8_WAIT_L(8); PG8_BAR; PG8_WAIT_L(0); PG8_MMA(0, 0, At, B0); PG8_BAR; PG8_SCHED;
            PG8_LDB(B1, 0, 1); PG8_STAGE(PG8_SB(0, 0), b2, voffB);
            PG8_BAR; PG8_WAIT_L(0); PG8_MMA(0, 1, At, B1); PG8_BAR;
            PG8_LDA(At, 0, 1); PG8_STAGE(PG8_SA(0, 0), a2, voffA);
            PG8_BAR; PG8_WAIT_L(0); PG8_MMA(1, 0, At, B0); PG8_BAR; PG8_SCHED;
            PG8_STAGE(PG8_SB(0, 1), b2 + hstep, voffB);
            PG8_WAIT_V(6); PG8_BAR; PG8_MMA(1, 1, At, B1); PG8_BAR;
            PG8_LDB(B0, 1, 0); PG8_SCHED; PG8_LDA(At, 1, 0); PG8_STAGE(PG8_SA(0, 1), a2 + hstep, voffA);
            PG8_WAIT_L(8); PG8_BAR; PG8_WAIT_L(0); PG8_MMA(0, 0, At, B0); PG8_BAR; PG8_SCHED;
            PG8_LDB(B1, 1, 1); PG8_STAGE(PG8_SB(1, 0), b3, voffB);
            PG8_BAR; PG8_WAIT_L(0); PG8_MMA(0, 1, At, B1); PG8_BAR;
            PG8_LDA(At, 1, 1); PG8_STAGE(PG8_SA(1, 0), a3, voffA);
            PG8_BAR; PG8_WAIT_L(0); PG8_MMA(1, 0, At, B0); PG8_BAR; PG8_SCHED;
            PG8_STAGE(PG8_SB(1, 1), b3 + hstep, voffB);
            PG8_WAIT_V(6); PG8_BAR; PG8_MMA(1, 1, At, B1); PG8_BAR;
            }
        }
        if constexpr (ALIGN_EPI) { if (wr == 0) PG8_BAR; }
        if constexpr (!Epi::AFTER_DRAIN) { E(acc, cur, wr, wc, fr, fq); S.done(cur); }
        if (!has_next) break;
#pragma unroll
        for (int a = 0; a < 2; ++a)
#pragma unroll
            for (int b = 0; b < 2; ++b)
#pragma unroll
                for (int m = 0; m < 4; ++m)
#pragma unroll
                    for (int n = 0; n < 2; ++n) acc[a][b][m][n] = (f32x4){0.f, 0.f, 0.f, 0.f};
        cur = nxt; cA = nA; cB = nB; ++ui;
        if constexpr (ALIGN_EPI) { if (wr == 1) PG8_BAR; }
    }
    PG8_WAIT_V(0);
    if constexpr (!ALIGN_EPI) { if (wr == 0) PG8_BAR; }
    PG8_BAR;
    if constexpr (Epi::AFTER_DRAIN) { E.fused(acc, cur, wr, wc, fr, fq, lds, wid, lane); S.done(cur); }
#undef PG8_SA
#undef PG8_SB
#undef PG8_STAGE
#undef PG8_LDA
#undef PG8_LDB
#undef PG8_MMA
#undef PG8_WAIT_V
#undef PG8_WAIT_L
#undef PG8_BAR
#undef PG8_SCHED
}
}

#ifndef PG8_SP2
#define PG8_SP2 true
#endif
#ifndef PG8_ALIGN
#define PG8_ALIGN true
#endif
namespace cg = cooperative_groups;
#define GAS __attribute__((address_space(1)))
#define LAS __attribute__((address_space(3)))
typedef unsigned short bf16;
typedef unsigned v4u __attribute__((ext_vector_type(4)));
typedef unsigned v2u __attribute__((ext_vector_type(2)));
typedef float f32x4 __attribute__((ext_vector_type(4)));
typedef float f32x2v __attribute__((ext_vector_type(2)));
typedef short bf16x8 __attribute__((ext_vector_type(8)));

constexpr int NWAVES = 8, NTHR = 512;
constexpr int BATCH = 4, T = 4096, D = 1024, M = BATCH * T, FF = 2816, NGU = 2 * FF, INW = 3088, LDP = 3328, CH = 64, NCH = T / CH;
constexpr int NUNITS = BATCH * 8 * NCH;
constexpr float RMS_EPS = 1e-6f;
constexpr size_t MiB = 1u << 20;
constexpr size_t WS_WGU1 = 0, WS_WD1 = 11 * MiB, WS_WIN = 33 * MiB / 2, WS_WOUT = 23 * MiB, WS_WGU2 = 25 * MiB, WS_WD2 = 36 * MiB;
constexpr size_t WS_TAB = 42 * MiB, WS_DEC = 43 * MiB, WS_H = 46 * MiB, WS_ST = WS_H, WS_PROJ = 78 * MiB, WS_ACT = WS_PROJ, WS_KV = 182 * MiB, WS_O = WS_KV, WS_END = 246 * MiB;
static_assert(WS_WD1 + (size_t)D * FF * 2 <= WS_WIN && WS_WIN + (size_t)LDP * D * 2 <= WS_WOUT && WS_WD2 + (size_t)D * FF * 2 <= WS_TAB, "ws map");
static_assert(WS_PROJ + (size_t)M * LDP * 2 <= WS_KV && WS_KV + (size_t)NUNITS * 8192 * 4 <= WS_END, "ws map");
constexpr size_t WS_CTL = 87 * MiB / 2, CTL_BYTES = 16384, WS_PART1 = 44 * MiB, WS_PART2 = 45 * MiB;
constexpr int LDS_BYTES = 147456, MISC_OFF = 131072 + 64;
constexpr int PB = 144;
constexpr int L_QP = 0, L_QM = 9216, L_KP = 18432, L_KM = 27648, L_QE = 36864, L_VT = 46080, L_PS = 64512, L_BS = 73728, L_LOW = 90368, L_TOT = 94464, L_RED = 96512, L_KDT = 0;

__device__ __forceinline__ unsigned pk2(float lo, float hi) { return pg8::cvt_pk_bf16(lo, hi); }
__device__ __forceinline__ float bf2f(unsigned h) { return __builtin_bit_cast(float, h << 16); }
__device__ __forceinline__ float bflo(unsigned w) { return __builtin_bit_cast(float, w << 16); }
__device__ __forceinline__ float bfhi(unsigned w) { return __builtin_bit_cast(float, w & 0xffff0000u); }
__device__ __forceinline__ float wave_sum(float v) {
#pragma unroll
    for (int o = 1; o < 64; o <<= 1) v += __shfl_xor(v, o);
    return v;
}
__device__ __forceinline__ float silu_f(float g) { return g * __builtin_amdgcn_rcpf(1.0f + __expf(-g)); }

#define XB_TMO      128
#define XB_XCNT(j)  (256  + 64 * (j))
#define XB_XSUB(j)  (1280 + 64 * (j))
#define XB_XGEN(j)  (2304 + 64 * (j))
#define XB_TOP      3328
#define XB_TOPGEN   3392
#define XCD_BAR_WORDS 3456
#define XB_SPIN_CAP (1u << 18)

__device__ __forceinline__ unsigned xb_ld(unsigned* p)              { return __hip_atomic_load(p, __ATOMIC_RELAXED, __HIP_MEMORY_SCOPE_AGENT); }
__device__ __forceinline__ unsigned xb_add(unsigned* p, unsigned v) { return __hip_atomic_fetch_add(p, v, __ATOMIC_RELAXED, __HIP_MEMORY_SCOPE_AGENT); }
__device__ __forceinline__ unsigned xb_xcc_id() { return (unsigned)__builtin_amdgcn_s_getreg((3 << 11) | 20) & 0xFu; }
#define XB_SPIN(cond, bar) do { unsigned _sp = 0; while (cond) { __builtin_amdgcn_s_sleep(1); \
    if ((++_sp & 255u) == 0u) { if (xb_ld(&(bar)[XB_TMO])) break; if (_sp > XB_SPIN_CAP) { atomicAdd(&(bar)[XB_TMO], 1u); break; } } } } while (0)

struct XcdBarrier {
    unsigned* bar; unsigned x;
    volatile LAS unsigned* st;
};

__device__ __forceinline__ XcdBarrier xcd_barrier_post(unsigned* bar, volatile LAS unsigned* st) {
    XcdBarrier b; b.bar = bar; b.x = xb_xcc_id(); b.st = st;
    if (threadIdx.x == 0) (void)xb_add(&bar[XB_XCNT(b.x)], 1u);
    return b;
}
__device__ __forceinline__ void xcd_barrier_complete(unsigned* bar, unsigned x, unsigned& nloc, unsigned& nx) {
    const unsigned G = gridDim.x * gridDim.y * gridDim.z;
    unsigned sum, cnt, mine, sp = 0u;
    for (;;) {
        sum = 0u; cnt = 0u; mine = 0u;
#pragma unroll
        for (unsigned j = 0; j < 16; ++j) { const unsigned c = xb_ld(&bar[XB_XCNT(j)]); sum += c; cnt += (c > 0u) ? 1u : 0u; mine = (j == x) ? c : mine; }
        if (sum == G) break;
        __builtin_amdgcn_s_sleep(1);
        if ((++sp & 255u) == 0u) { if (xb_ld(&bar[XB_TMO])) break; if (sp > XB_SPIN_CAP) { atomicAdd(&bar[XB_TMO], 1u); break; } }
    }
    nloc = mine > 0u ? mine : 1u; nx = cnt > 0u ? cnt : 1u;
}

__device__ __forceinline__ void xcd_barrier(const XcdBarrier& b) {
    asm volatile("s_waitcnt vmcnt(0)" ::: "memory");
    __syncthreads();
    if (threadIdx.x == 0) {
        unsigned* bar = b.bar;
        __builtin_amdgcn_s_waitcnt(0);
        unsigned nloc = b.st[0], nx = b.st[1];
        if (nloc == 0u) { xcd_barrier_complete(bar, b.x, nloc, nx); b.st[0] = nloc; b.st[1] = nx; }
        const unsigned old = xb_add(&bar[XB_XSUB(b.x)], 1u);
        const unsigned gen = old / nloc;
        if (old + 1u == (gen + 1u) * nloc) {
            __builtin_amdgcn_fence(__ATOMIC_RELEASE, "agent");
            asm volatile("s_waitcnt vmcnt(0)" ::: "memory");
            const unsigned og = xb_add(&bar[XB_TOP], 1u);
            const unsigned tg = og / nx;
            if (og + 1u == (tg + 1u) * nx) xb_add(&bar[XB_TOPGEN], 1u);
            else XB_SPIN(xb_ld(&bar[XB_TOPGEN]) == tg, bar);
            __builtin_amdgcn_fence(__ATOMIC_ACQUIRE, "agent");
            xb_add(&bar[XB_XGEN(b.x)], 1u);
            asm volatile("s_waitcnt vmcnt(0)" ::: "memory");
        } else {
            XB_SPIN(xb_ld(&bar[XB_XGEN(b.x)]) == gen, bar);
            __builtin_amdgcn_fence(__ATOMIC_ACQUIRE, "agent");
            asm volatile("s_waitcnt vmcnt(0)" ::: "memory");
        }
    }
    __syncthreads();
}

__device__ __forceinline__ float row_rstd(const float* part, int row) {
    const pg8::f32x4* p = (const pg8::f32x4*)(part + (size_t)row * 16); const pg8::f32x4 a = p[0], b = p[1], c = p[2], d = p[3];
    const float s = ((a[0] + a[1]) + (a[2] + a[3])) + ((b[0] + b[1]) + (b[2] + b[3])) + ((c[0] + c[1]) + (c[2] + c[3])) + ((d[0] + d[1]) + (d[2] + d[3]));
    return 1.0f / sqrtf(s * (1.f / D) + RMS_EPS);
}
constexpr int RS_OFF = 131072 + 256, RS_UNITS = 14;
template <class Sched> __device__ __forceinline__ void fill_rstd(LAS unsigned char* lds, const Sched& S, const float* part, int tid) {
    LAS float* rs = (LAS float*)(lds + RS_OFF); pg8::Unit u;
    for (int i = 0; i < RS_UNITS && S.next(i, u); ++i) if (tid < 256) rs[i * 256 + tid] = row_rstd(part, u.pm * 256 + tid);
    __syncthreads();
}
template <bool SCALED> struct EpiSwiGLU {
    static constexpr bool PERM = true, AFTER_DRAIN = false;
    bf16* O; int ldc; const LAS float* rs;
    __device__ __forceinline__ void operator()(const pg8::f32x4 (&acc)[2][2][4][2], const pg8::Unit& u, int wr, int wc, int fr, int fq) const {
        const int row0 = u.pm * 256 + wr * 64 + fr, col0 = u.pn * 128 + wc * 32 + 8 * fq;
#pragma unroll
        for (int ai = 0; ai < 2; ++ai)
#pragma unroll
            for (int m = 0; m < 4; ++m) {
                const int row = row0 + ai * 128 + m * 16;
                const float r = SCALED ? rs[(u.ord < RS_UNITS ? u.ord : 0) * 256 + (row & 255)] : 1.0f;
                bf16* rowp = O + (size_t)row * ldc + col0;
                const pg8::f32x4 g0 = acc[ai][0][m][0] * r, g1 = acc[ai][0][m][1] * r, u0 = acc[ai][1][m][0] * r, u1 = acc[ai][1][m][1] * r;
                v4u w;
                w.x = pk2(silu_f(g0[0]) * u0[0], silu_f(g0[1]) * u0[1]); w.y = pk2(silu_f(g0[2]) * u0[2], silu_f(g0[3]) * u0[3]);
                w.z = pk2(silu_f(g1[0]) * u1[0], silu_f(g1[1]) * u1[1]); w.w = pk2(silu_f(g1[2]) * u1[2], silu_f(g1[3]) * u1[3]);
                *(v4u*)rowp = w;
            }
    }
};
struct EpiProj {
    static constexpr bool PERM = true, AFTER_DRAIN = false;
    bf16* O; int ldc; const LAS float* rs;
    __device__ __forceinline__ void operator()(const pg8::f32x4 (&acc)[2][2][4][2], const pg8::Unit& u, int wr, int wc, int fr, int fq) const {
        const int row0 = u.pm * 256 + wr * 64 + fr, col0 = u.pn * 256 + wc * 32 + 8 * fq;
#pragma unroll
        for (int ai = 0; ai < 2; ++ai)
#pragma unroll
            for (int m = 0; m < 4; ++m) {
                const int row = row0 + ai * 128 + m * 16;
                const float r = rs[(u.ord < RS_UNITS ? u.ord : 0) * 256 + (row & 255)];
                bf16* rowp = O + (size_t)row * ldc + col0;
#pragma unroll
                for (int bj = 0; bj < 2; ++bj) { const pg8::f32x4 v0 = acc[ai][bj][m][0] * r, v1 = acc[ai][bj][m][1] * r;
                    v4u w; w.x = pk2(v0[0], v0[1]); w.y = pk2(v0[2], v0[3]); w.z = pk2(v1[0], v1[1]); w.w = pk2(v1[2], v1[3]);
                    *(v4u*)(rowp + bj * 128) = w; }
            }
    }
};
template <bool STATS, size_t XB_OFF, size_t PART_OFF> struct EpiResid {
    static constexpr bool PERM = false, AFTER_DRAIN = false;
    const float* base; float* out; unsigned char* wsb; float scale;
    __device__ __forceinline__ void operator()(const pg8::f32x4 (&acc)[2][2][4][2], const pg8::Unit& u, int wr, int wc, int fr, int fq) const {
        constexpr int ldc = D;
        const int col0 = u.pn * 256 + wc * 32 + 4 * fq;
        unsigned char* w = wsb; asm volatile("" : "+s"(w));
        bf16* const xb = (bf16*)(w + XB_OFF); float* const part = (float*)(w + PART_OFF);
#pragma unroll
        for (int ai = 0; ai < 2; ++ai)
#pragma unroll
            for (int m = 0; m < 4; ++m) {
                const int row = u.pm * 256 + ai * 128 + wr * 64 + m * 16 + fr;
                const size_t off = (size_t)row * ldc + col0;
                float ss = 0.f;
#pragma unroll
                for (int bj = 0; bj < 2; ++bj)
#pragma unroll
                    for (int n = 0; n < 2; ++n) {
                        const pg8::f32x4 bs = *(const pg8::f32x4*)(base + off + bj * 128 + n * 16);
                        const pg8::f32x4 o = bs + acc[ai][bj][m][n] * scale;
                        *(pg8::f32x4*)(out + off + bj * 128 + n * 16) = o;
                        if (STATS) { *(v2u*)(xb + off + bj * 128 + n * 16) = (v2u){pk2(o[0], o[1]), pk2(o[2], o[3])}; ss += (o[0] * o[0] + o[1] * o[1]) + (o[2] * o[2] + o[3] * o[3]); }
                    }
                if (STATS) { ss += __shfl_xor(ss, 16); ss += __shfl_xor(ss, 32); if (fq == 0) part[(size_t)row * 16 + u.pn * 4 + wc] = ss; }
                asm volatile("" ::: "memory");
            }
    }
};

__device__ __forceinline__ void transpose_item(const float* W, int K, int N, bf16* WT, int nblk, int mode, LAS float* scr, int item, int lane, const float* gk = nullptr) {
    const int kb = item / nblk, nb = item % nblk, k0 = 64 * kb, n0 = 32 * nb;
    const int nn = n0 + (lane & 31); const bool ok = nn < N;
#pragma unroll 8
    for (int i = 0; i < 32; ++i) { const int kk = 2 * i + (lane >> 5); scr[kk * 33 + (lane & 31)] = ok ? W[(size_t)(k0 + kk) * N + nn] * (gk ? gk[k0 + kk] : 1.0f) : 0.f; }
    asm volatile("s_waitcnt lgkmcnt(0)" ::: "memory");
    const int c = lane & 7;
    const int drow0 = mode == 0 ? n0 : (256 * (n0 >> 7) + (n0 & 127) + (mode == 2 ? 128 : 0));
#pragma unroll
    for (int j = 0; j < 4; ++j) { const int n = (lane >> 3) + 8 * j; const LAS float* s = scr + (8 * c) * 33 + n;
        v4u o; o.x = pk2(s[0 * 33], s[1 * 33]); o.y = pk2(s[2 * 33], s[3 * 33]); o.z = pk2(s[4 * 33], s[5 * 33]); o.w = pk2(s[6 * 33], s[7 * 33]);
        *(v4u*)(WT + (size_t)(drow0 + n) * K + k0 + 8 * c) = o; }
    asm volatile("s_waitcnt lgkmcnt(0)" ::: "memory");
}
__device__ __forceinline__ void norm_row_bf16(const float* xrow, const float* g, bf16* orow, int lane) {
    const f32x4* xr = (const f32x4*)xrow + lane; const f32x4* gr = (const f32x4*)g + lane;
    f32x4 v[4]; float s = 0.f;
#pragma unroll
    for (int j = 0; j < 4; ++j) { v[j] = xr[64 * j]; s += (v[j].x * v[j].x + v[j].y * v[j].y) + (v[j].z * v[j].z + v[j].w * v[j].w); }
    const float r = 1.0f / sqrtf(wave_sum(s) * (1.f / D) + RMS_EPS);
    v2u* o8 = (v2u*)orow + lane;
#pragma unroll
    for (int j = 0; j < 4; ++j) { const f32x4 gg = gr[64 * j]; v2u o; o.x = pk2(v[j].x * r * gg.x, v[j].y * r * gg.y); o.y = pk2(v[j].z * r * gg.z, v[j].w * r * gg.w); o8[64 * j] = o; }
}
__device__ __forceinline__ void norm_row_f32(float* xrow, const float* g, int lane) {
    f32x4* xr = (f32x4*)xrow + lane; const f32x4* gr = (const f32x4*)g + lane;
    f32x4 v[4]; float s = 0.f;
#pragma unroll
    for (int j = 0; j < 4; ++j) { v[j] = xr[64 * j]; s += (v[j].x * v[j].x + v[j].y * v[j].y) + (v[j].z * v[j].z + v[j].w * v[j].w); }
    const float r = 1.0f / sqrtf(wave_sum(s) * (1.f / D) + RMS_EPS);
#pragma unroll
    for (int j = 0; j < 4; ++j) { const f32x4 gg = gr[64 * j]; xr[64 * j] = (f32x4){v[j].x * r * gg.x, v[j].y * r * gg.y, v[j].z * r * gg.z, v[j].w * r * gg.w}; }
}

#define LBAR() do { asm volatile("s_waitcnt lgkmcnt(0)" ::: "memory"); __builtin_amdgcn_s_barrier(); asm volatile("" ::: "memory"); } while (0)
struct UnitInfo { int b, h8, n, h; bool gla; size_t m0; int qcol, kcol, vcol, gcol, ocol; };
__device__ __forceinline__ UnitInfo unit_info(int u) {
    UnitInfo I; I.n = u & 63; I.h8 = (u >> 6) & 7; I.b = u >> 9; I.gla = I.h8 >= 4; I.h = I.h8 & 3; I.m0 = (size_t)I.b * T + (size_t)I.n * CH;
    const int base = I.gla ? 1536 : 0;
    I.qcol = base + 64 * I.h; I.kcol = base + 256 + 64 * I.h; I.vcol = base + 512 + 128 * I.h; I.gcol = base + 1024 + 128 * I.h; I.ocol = (I.gla ? 512 : 0) + 128 * I.h;
    return I;
}
struct RawIn { unsigned low; v2u q0, q1, k0, k1; f32x4 t0, t1; v4u v0, v1; f32x4 wa0, wa1, wa2, wa3; float ba; };
template <bool NEED_Q>
__device__ __forceinline__ void attn_load(RawIn& R, int u, const bf16* proj, const float* tab, const float* w_a2, const float* b_a, int tid) {
    const UnitInfo I = unit_info(u);
    { const int j = tid >> 3, g = tid & 7; const bf16* rp = proj + (I.m0 + j) * LDP;
      R.low = *(const unsigned*)(rp + 3072 + 2 * g);
      R.k0 = *(const v2u*)(rp + I.kcol + 4 * g); R.k1 = *(const v2u*)(rp + I.kcol + 32 + 4 * g);
      if (NEED_Q) { R.q0 = *(const v2u*)(rp + I.qcol + 4 * g); R.q1 = *(const v2u*)(rp + I.qcol + 32 + 4 * g); }
      const float* tp = tab + ((size_t)(I.n * CH + j) * 32 + 4 * g) * 2; R.t0 = ((const f32x4*)tp)[0]; R.t1 = ((const f32x4*)tp)[1]; }
    { const int c = tid & 15, j = tid >> 4; R.v0 = *(const v4u*)(proj + (I.m0 + j) * LDP + I.vcol + 8 * c); R.v1 = *(const v4u*)(proj + (I.m0 + j + 32) * LDP + I.vcol + 8 * c); }
    { const int k = tid & 63; const float* wp = w_a2 + 64 * I.h + k;
      R.wa0 = (f32x4){wp[0], wp[256], wp[512], wp[768]}; R.wa1 = (f32x4){wp[1024], wp[1280], wp[1536], wp[1792]};
      R.wa2 = (f32x4){wp[2048], wp[2304], wp[2560], wp[2816]}; R.wa3 = (f32x4){wp[3072], wp[3328], wp[3584], wp[3840]}; R.ba = b_a[64 * I.h + k]; }
}
__device__ __forceinline__ void attn_compute_b(LAS unsigned char* lds, const UnitInfo& I, const RawIn& R, int tid) {
    LAS float* BS = (LAS float*)(lds + L_BS); LAS float* LOW = (LAS float*)(lds + L_LOW); LAS float* TOT = (LAS float*)(lds + L_TOT);
    const int k = tid & 63, w = tid >> 6;
    if (I.gla) {
        { const int j = tid >> 3, r = (tid & 7) * 2; LOW[j * 16 + r] = bflo(R.low); LOW[j * 16 + r + 1] = bfhi(R.low); }
        LBAR();
        float la[8]; float run = 0.f;
#pragma unroll
        for (int jj = 0; jj < 8; ++jj) {
            const LAS f32x4* lp = (const LAS f32x4*)(LOW + (8 * w + jj) * 16);
            const f32x4 l0 = lp[0], l1 = lp[1], l2 = lp[2], l3 = lp[3];
            float z = R.ba;
            z += l0.x * R.wa0.x + l0.y * R.wa0.y + l0.z * R.wa0.z + l0.w * R.wa0.w;
            z += l1.x * R.wa1.x + l1.y * R.wa1.y + l1.z * R.wa1.z + l1.w * R.wa1.w;
            z += l2.x * R.wa2.x + l2.y * R.wa2.y + l2.z * R.wa2.z + l2.w * R.wa2.w;
            z += l3.x * R.wa3.x + l3.y * R.wa3.y + l3.z * R.wa3.z + l3.w * R.wa3.w;
            const float ls = fminf(z, 0.f) - __logf(1.0f + __expf(-fabsf(z)));
            run += ls * 0.0625f; la[jj] = run;
        }
        TOT[w * 64 + k] = run;
        LBAR();
        float off = 0.f;
#pragma unroll
        for (int w2 = 0; w2 < 7; ++w2) off += (w2 < w) ? TOT[w2 * 64 + k] : 0.f;
#pragma unroll
        for (int jj = 0; jj < 8; ++jj) BS[(8 * w + jj) * 65 + k] = la[jj] + off;
    } else {
        const float lg = __logf(1.0f - exp2f(-5.0f - (float)I.h));
#pragma unroll
        for (int jj = 0; jj < 8; ++jj) BS[(8 * w + jj) * 65 + k] = (float)(8 * w + jj + 1) * lg;
    }
    LBAR();
}
__device__ __forceinline__ void unpack8(const v2u x, const v2u y, float (&lo)[4], float (&hi)[4]) {
    lo[0] = bflo(x.x); lo[1] = bfhi(x.x); lo[2] = bflo(x.y); lo[3] = bfhi(x.y);
    hi[0] = bflo(y.x); hi[1] = bfhi(y.x); hi[2] = bflo(y.y); hi[3] = bfhi(y.y);
}
__device__ __forceinline__ void rotary8(const f32x4 t0, const f32x4 t1, float (&lo)[4], float (&hi)[4]) {
    const float c[4] = {t0.x, t0.z, t1.x, t1.z}, s[4] = {t0.y, t0.w, t1.y, t1.w};
#pragma unroll
    for (int e = 0; e < 4; ++e) { const float a = lo[e], b = hi[e]; lo[e] = a * c[e] - b * s[e]; hi[e] = a * s[e] + b * c[e]; }
}
__device__ __forceinline__ int swz_off(int row, int col) { return row * PB + ((((col >> 3) ^ (row >> 3)) & 7) << 4) + (col & 7) * 2; }
__device__ __forceinline__ void stage_vt(LAS unsigned char* lds, const RawIn& R, int tid) {
    const int c = tid & 15;
#pragma unroll
    for (int p = 0; p < 2; ++p) {
        const int j = (tid >> 4) + 32 * p;
        const v4u x = p ? R.v1 : R.v0;
        const unsigned xs[4] = {x.x, x.y, x.z, x.w};
#pragma unroll
        for (int e = 0; e < 8; ++e) { const unsigned short val = (unsigned short)((xs[e >> 1] >> (16 * (e & 1))) & 0xffffu);
            *(LAS unsigned short*)(lds + L_VT + swz_off(8 * c + e, j)) = val; }
    }
}
__device__ __forceinline__ bf16x8 frag_plain(LAS unsigned char* base, int t16, int kk, int lane) { const int row = 16 * t16 + (lane & 15); return *(const LAS bf16x8*)(base + row * PB + (32 * kk + 8 * (lane >> 4)) * 2); }
__device__ __forceinline__ bf16x8 frag_swz(LAS unsigned char* base, int t16, int kk, int lane) { const int row = 16 * t16 + (lane & 15); const int jc = 4 * kk + (lane >> 4); return *(const LAS bf16x8*)(base + row * PB + (((jc ^ (row >> 3)) & 7) << 4)); }
#define MFMA16(X, Y, C) __builtin_amdgcn_mfma_f32_16x16x32_bf16((X), (Y), (C), 0, 0, 0)

__device__ __forceinline__ void attn_pass_a(LAS unsigned char* lds, int u, const RawIn& R, float* KV, float* DEC, int tid) {
    const UnitInfo I = unit_info(u); const int lane = tid & 63, w = tid >> 6;
    LAS float* BS = (LAS float*)(lds + L_BS);
    attn_compute_b(lds, I, R, tid);
    {
        const int j = tid >> 3, g = tid & 7;
        float klo[4], khi[4];
        unpack8(R.k0, R.k1, klo, khi);
        if (!I.gla) { rotary8(R.t0, R.t1, klo, khi);
#pragma unroll
            for (int e = 0; e < 4; ++e) { klo[e] *= 0.125f; khi[e] *= 0.125f; } }
#pragma unroll
        for (int e = 0; e < 4; ++e) {
            const int c0 = 4 * g + e, c1 = c0 + 32;
            const float d0 = __expf(BS[63 * 65 + c0] - BS[j * 65 + c0]), d1 = __expf(BS[63 * 65 + c1] - BS[j * 65 + c1]);
            *(LAS unsigned short*)(lds + L_KDT + swz_off(c0, j)) = (unsigned short)(pk2(klo[e] * d0, 0.f) & 0xffffu);
            *(LAS unsigned short*)(lds + L_KDT + swz_off(c1, j)) = (unsigned short)(pk2(khi[e] * d1, 0.f) & 0xffffu);
        }
        if (tid < 64) DEC[(size_t)u * 64 + tid] = __expf(BS[63 * 65 + tid]);
    }
    stage_vt(lds, R, tid);
    LBAR();
    {
        const int vt = w; float* KVu = KV + (size_t)u * 8192;
#pragma unroll
        for (int kt = 0; kt < 4; ++kt) {
            f32x4 acc = {0.f, 0.f, 0.f, 0.f};
#pragma unroll
            for (int kk = 0; kk < 2; ++kk) acc = MFMA16(frag_swz(lds + L_VT, vt, kk, lane), frag_swz(lds + L_KDT, kt, kk, lane), acc);
            const int v0 = 16 * vt + 4 * (lane >> 4), k = 16 * kt + (lane & 15);
#pragma unroll
            for (int e = 0; e < 4; ++e) KVu[(v0 + e) * 64 + k] = acc[e];
        }
    }
}
__device__ __forceinline__ void attn_pass_c(LAS unsigned char* lds, int u, const RawIn& R, const bf16* proj, const bf16* ST, const float* ng_ret, const float* ng_gla, bf16* O, int tid) {
    const UnitInfo I = unit_info(u); const int lane = tid & 63, w = tid >> 6;
    LAS float* BS = (LAS float*)(lds + L_BS); LAS float* RED = (LAS float*)(lds + L_RED);
    const int it_o = w & 3, vh = w >> 2, i_o = 16 * it_o + (lane & 15);
    bf16x8 stf[2][4]; v2u gv[4]; f32x4 g4[4];
    { const bf16* STu = ST + (size_t)u * 8192;
#pragma unroll
      for (int kk = 0; kk < 2; ++kk)
#pragma unroll
          for (int a = 0; a < 4; ++a) stf[kk][a] = *(const bf16x8*)(STu + (16 * (4 * vh + a) + (lane & 15)) * 64 + 32 * kk + 8 * (lane >> 4));
      const float* ng = (I.gla ? ng_gla : ng_ret) + 128 * I.h; const bf16* grow = proj + (I.m0 + i_o) * LDP + I.gcol;
#pragma unroll
      for (int a = 0; a < 4; ++a) { const int v0 = 16 * (4 * vh + a) + 4 * (lane >> 4); gv[a] = *(const v2u*)(grow + v0); g4[a] = *(const f32x4*)(ng + v0); } }
    attn_compute_b(lds, I, R, tid);
    {
        const int j = tid >> 3, g = tid & 7;
        float qlo[4], qhi[4], klo[4], khi[4];
        unpack8(R.q0, R.q1, qlo, qhi); unpack8(R.k0, R.k1, klo, khi);
        if (!I.gla) { rotary8(R.t0, R.t1, qlo, qhi); rotary8(R.t0, R.t1, klo, khi);
#pragma unroll
            for (int e = 0; e < 4; ++e) { klo[e] *= 0.125f; khi[e] *= 0.125f; } }
        else {
#pragma unroll
            for (int e = 0; e < 4; ++e) { qlo[e] *= 0.125f; qhi[e] *= 0.125f; } }
        float qp[8], qm[8], kp[8], km[8], qe[8];
#pragma unroll
        for (int e = 0; e < 4; ++e) {
            const int c0 = 4 * g + e, c1 = c0 + 32;
            const float b0 = BS[j * 65 + c0], b1 = BS[j * 65 + c1], r0 = BS[32 * 65 + c0], r1 = BS[32 * 65 + c1];
            const float p0 = __expf(b0 - r0), m0 = __expf(r0 - b0), p1 = __expf(b1 - r1), m1 = __expf(r1 - b1), e0 = __expf(b0), e1 = __expf(b1);
            qp[e] = qlo[e] * p0; qm[e] = qlo[e] * m0; kp[e] = klo[e] * p0; km[e] = klo[e] * m0; qe[e] = qlo[e] * e0;
            qp[4 + e] = qhi[e] * p1; qm[4 + e] = qhi[e] * m1; kp[4 + e] = khi[e] * p1; km[4 + e] = khi[e] * m1; qe[4 + e] = qhi[e] * e1;
        }
        const int o0 = j * PB + 8 * g, o1 = o0 + 64;
#define ST8(OFF, A) do { *(LAS v2u*)(lds + (OFF) + o0) = (v2u){pk2(A[0], A[1]), pk2(A[2], A[3])}; *(LAS v2u*)(lds + (OFF) + o1) = (v2u){pk2(A[4], A[5]), pk2(A[6], A[7])}; } while (0)
        ST8(L_QP, qp); ST8(L_QM, qm); ST8(L_KP, kp); ST8(L_KM, km); ST8(L_QE, qe);
#undef ST8
    }
    stage_vt(lds, R, tid);
    LBAR();
    {
        const int jt = w & 3;
#pragma unroll
        for (int ii = 0; ii < 2; ++ii) {
            const int it = (w >> 2) * 2 + ii;
            f32x4 lo = {0.f, 0.f, 0.f, 0.f}, hi = {0.f, 0.f, 0.f, 0.f};
#pragma unroll
            for (int kk = 0; kk < 2; ++kk) { lo = MFMA16(frag_plain(lds + L_KM, jt, kk, lane), frag_plain(lds + L_QP, it, kk, lane), lo);
                                             hi = MFMA16(frag_plain(lds + L_KP, jt, kk, lane), frag_plain(lds + L_QM, it, kk, lane), hi); }
            const int i = 16 * it + (lane & 15), j0 = 16 * jt + 4 * (lane >> 4);
            float s[4];
#pragma unroll
            for (int e = 0; e < 4; ++e) s[e] = (j0 + e <= i) ? lo[e] : hi[e];
            *(LAS v2u*)(lds + L_PS + i * PB + j0 * 2) = (v2u){pk2(s[0], s[1]), pk2(s[2], s[3])};
        }
    }
    LBAR();
    {
        f32x4 acc[4];
#pragma unroll
        for (int a = 0; a < 4; ++a) acc[a] = (f32x4){0.f, 0.f, 0.f, 0.f};
#pragma unroll
        for (int kk = 0; kk < 2; ++kk) {
            const bf16x8 y1 = frag_plain(lds + L_PS, it_o, kk, lane), y2 = frag_plain(lds + L_QE, it_o, kk, lane);
#pragma unroll
            for (int a = 0; a < 4; ++a) { const int vt = 4 * vh + a;
                acc[a] = MFMA16(frag_swz(lds + L_VT, vt, kk, lane), y1, acc[a]);
                acc[a] = MFMA16(stf[kk][a], y2, acc[a]); }
        }
        float ss = 0.f;
#pragma unroll
        for (int a = 0; a < 4; ++a) ss += (acc[a].x * acc[a].x + acc[a].y * acc[a].y) + (acc[a].z * acc[a].z + acc[a].w * acc[a].w);
        ss += __shfl_xor(ss, 16); ss += __shfl_xor(ss, 32);
        if ((lane >> 4) == 0) RED[i_o * 2 + vh] = ss;
        LBAR();
        const float r = 1.0f / sqrtf((RED[i_o * 2] + RED[i_o * 2 + 1]) * (1.f / 128.f) + RMS_EPS);
        bf16* orow = O + (I.m0 + i_o) * D + I.ocol;
#pragma unroll
        for (int a = 0; a < 4; ++a) { const int v0 = 16 * (4 * vh + a) + 4 * (lane >> 4);
            const float o0 = acc[a].x * r * g4[a].x * silu_f(bflo(gv[a].x)), o1 = acc[a].y * r * g4[a].y * silu_f(bfhi(gv[a].x)), o2 = acc[a].z * r * g4[a].z * silu_f(bflo(gv[a].y)), o3 = acc[a].w * r * g4[a].w * silu_f(bfhi(gv[a].y));
            *(v2u*)(orow + v0) = (v2u){pk2(o0, o1), pk2(o2, o3)}; }
    }
}
struct Args { const float* in[17]; float* out; unsigned char* ws; int ph_lo, ph_hi; };
constexpr int N_PHASES = 11;
__global__ void __launch_bounds__(NTHR, 2) fwd_kernel(Args a) {
    extern __shared__ __attribute__((aligned(16))) unsigned char lds_raw[];
    LAS unsigned char* lds = (LAS unsigned char*)lds_raw;
    cg::grid_group grid = cg::this_grid();
    const int tid = threadIdx.x, lane = tid & 63, wave = __builtin_amdgcn_readfirstlane(tid >> 6);
    const int G = gridDim.x, bx = blockIdx.x;
    const int gw = bx * NWAVES + wave, NGW = G * NWAVES;
    const long gt = (long)bx * NTHR + tid, NGT = (long)G * NTHR;
    unsigned char* ws = a.ws;
    const float* x = a.in[0];
    const float *ffn1_g = a.in[1], *ffn1_wg = a.in[2], *ffn1_wu = a.in[3], *ffn1_wd = a.in[4], *mix_g = a.in[5], *w_in = a.in[6], *ret_ng = a.in[7], *w_a2 = a.in[8], *b_a = a.in[9],
                *gla_ng = a.in[10], *w_out = a.in[11], *ffn2_g = a.in[12], *ffn2_wg = a.in[13], *ffn2_wu = a.in[14], *ffn2_wd = a.in[15], *fin_g = a.in[16];
    float* out = a.out;
    bf16 *Wgu1 = (bf16*)(ws + WS_WGU1), *Wd1 = (bf16*)(ws + WS_WD1), *Win = (bf16*)(ws + WS_WIN), *Wout = (bf16*)(ws + WS_WOUT), *Wgu2 = (bf16*)(ws + WS_WGU2), *Wd2 = (bf16*)(ws + WS_WD2);
    float* TAB = (float*)(ws + WS_TAB); float* DEC = (float*)(ws + WS_DEC); bf16* H = (bf16*)(ws + WS_H); bf16* STb = (bf16*)(ws + WS_ST);
    bf16* PROJ = (bf16*)(ws + WS_PROJ); bf16* ACT = (bf16*)(ws + WS_ACT); float* KV = (float*)(ws + WS_KV); bf16* Ob = (bf16*)(ws + WS_O); float* PART1 = (float*)(ws + WS_PART1); float* PART2 = (float*)(ws + WS_PART2);
    const int lo = a.ph_lo, hi = a.ph_hi;
    if (tid < 16) ((LAS unsigned*)(lds + 131072))[tid + 0] = 0u;
    if (tid < 32) ((LAS unsigned*)(lds + 131072))[tid + 16] = 0u;
    __syncthreads();
    XcdBarrier bar = xcd_barrier_post((unsigned*)(ws + WS_CTL), (volatile LAS unsigned*)(lds + MISC_OFF));
    if (hi > 1000) grid.sync();
#define IN(k) (lo <= (k) && (k) < hi)
#define SEAM(k) do { if (IN(k) && IN((k) + 1)) xcd_barrier(bar); } while (0)

    if (IN(0)) {
        LAS float* scr = (LAS float*)(lds + wave * 16384);
        constexpr int I_G = (D / 64) * (FF / 32), I_D = (FF / 64) * (D / 32), I_IN = (D / 64) * 97, I_O = (D / 64) * (D / 32);
        constexpr int NITEMS = 6 * I_G + I_IN + I_O;
        static_assert(I_G == I_D, "items");
        for (int it = gw; it < NITEMS; it += NGW) {
            int r = it;
            if (r < I_G) { transpose_item(ffn1_wg, D, FF, Wgu1, FF / 32, 1, scr, r, lane); continue; } r -= I_G;
            if (r < I_G) { transpose_item(ffn1_wu, D, FF, Wgu1, FF / 32, 2, scr, r, lane); continue; } r -= I_G;
            if (r < I_D) { transpose_item(ffn1_wd, FF, D, Wd1, D / 32, 0, scr, r, lane); continue; } r -= I_D;
            if (r < I_G) { transpose_item(ffn2_wg, D, FF, Wgu2, FF / 32, 1, scr, r, lane, ffn2_g); continue; } r -= I_G;
            if (r < I_G) { transpose_item(ffn2_wu, D, FF, Wgu2, FF / 32, 2, scr, r, lane, ffn2_g); continue; } r -= I_G;
            if (r < I_D) { transpose_item(ffn2_wd, FF, D, Wd2, D / 32, 0, scr, r, lane); continue; } r -= I_D;
            if (r < I_IN) { transpose_item(w_in, D, INW, Win, 97, 0, scr, r, lane, mix_g); continue; } r -= I_IN;
            transpose_item(w_out, D, D, Wout, D / 32, 0, scr, r, lane);
        }
        { v4u* z = (v4u*)(Win + (size_t)3104 * D); const long nz = (long)(LDP - 3104) * D * 2 / 16; for (long i = gt; i < nz; i += NGT) z[i] = (v4u){0u, 0u, 0u, 0u}; }
        for (long i = gt; i < (long)T * 32; i += NGT) { const int pos = (int)(i >> 5), f = (int)(i & 31);
            const float inv = powf(10000.0f, -(float)f * (1.0f / 32.0f)); const float ang = (float)pos * inv;
            *(f32x2v*)(TAB + 2 * i) = (f32x2v){cosf(ang), sinf(ang)}; }
        for (int m = gw; m < M; m += NGW) norm_row_bf16(x + (size_t)m * D, ffn1_g, H + (size_t)m * D, lane);
    }
    SEAM(0);
    if (IN(1)) { pg8::Gemm g{H, Wgu1, M, NGU, D}; pg8::StaticOrder S; S.init(M, NGU, G, bx); EpiSwiGLU<false> E{ACT, FF, nullptr};
        pg8::gemm_phase<EpiSwiGLU<false>, pg8::StaticOrder, PG8_ALIGN, PG8_SP2>(lds, g, S, E); }
    SEAM(1);
    if (IN(2)) { pg8::Gemm g{ACT, Wd1, M, D, FF}; pg8::StaticOrder S; S.init(M, D, G, bx); typedef EpiResid<true, WS_H, WS_PART1> Ep; Ep E{x, out, ws, 0.5f};
        pg8::gemm_phase<Ep, pg8::StaticOrder, PG8_ALIGN, PG8_SP2>(lds, g, S, E); }
    SEAM(2);
    if (IN(3)) { pg8::Gemm g{H, Win, M, LDP, D}; pg8::StaticOrder S; S.init(M, LDP, G, bx); fill_rstd(lds, S, PART1, tid); EpiProj E{PROJ, LDP, (const LAS float*)(lds + RS_OFF)};
        pg8::gemm_phase<EpiProj, pg8::StaticOrder, PG8_ALIGN, PG8_SP2>(lds, g, S, E); }
    SEAM(3);
    if (IN(4) && bx < NUNITS) {
        RawIn cur; attn_load<false>(cur, bx, PROJ, TAB, w_a2, b_a, tid);
        __builtin_amdgcn_s_waitcnt(0x0F70);
        for (int u = bx; u < NUNITS; u += G) { RawIn nxt; attn_load<false>(nxt, (u + G < NUNITS) ? u + G : u, PROJ, TAB, w_a2, b_a, tid);
            attn_pass_a(lds, u, cur, KV, DEC, tid);
            __builtin_amdgcn_sched_barrier(0); __builtin_amdgcn_s_waitcnt(0x4F70); __builtin_amdgcn_sched_barrier(0); cur = nxt; }
    }
    SEAM(4);
    if (IN(5)) {
        for (long e2 = gt; e2 < (long)BATCH * 8 * 4096; e2 += NGT) {
            const int bh = (int)(e2 >> 12), el = (int)(e2 & 4095) * 2, k = el & 63;
            float r0 = 0.f, r1 = 0.f;
            for (int n0 = 0; n0 < NCH; n0 += 8) {
                f32x2v kv[8], dc[8];
#pragma unroll
                for (int q = 0; q < 8; ++q) { const size_t uu = (size_t)bh * 64 + n0 + q; kv[q] = *(const f32x2v*)(KV + uu * 8192 + el); dc[q] = *(const f32x2v*)(DEC + uu * 64 + k); }
#pragma unroll
                for (int q = 0; q < 8; ++q) { const size_t uu = (size_t)bh * 64 + n0 + q; *(unsigned*)(STb + uu * 8192 + el) = pk2(r0, r1); r0 = dc[q].x * r0 + kv[q].x; r1 = dc[q].y * r1 + kv[q].y; }
            }
        }
    }
    SEAM(5);
    if (IN(6) && bx < NUNITS) {
        RawIn cur; attn_load<true>(cur, bx, PROJ, TAB, w_a2, b_a, tid);
        __builtin_amdgcn_s_waitcnt(0x0F70);
        for (int u = bx; u < NUNITS; u += G) { RawIn nxt; attn_load<true>(nxt, (u + G < NUNITS) ? u + G : u, PROJ, TAB, w_a2, b_a, tid);
            attn_pass_c(lds, u, cur, PROJ, STb, ret_ng, gla_ng, Ob, tid);
            __builtin_amdgcn_sched_barrier(0); __builtin_amdgcn_s_waitcnt(0x0F74); __builtin_amdgcn_sched_barrier(0); cur = nxt; }
    }
    SEAM(6);
    if (IN(7)) { pg8::Gemm g{Ob, Wout, M, D, D}; pg8::StaticOrder S; S.init(M, D, G, bx); typedef EpiResid<true, WS_H, WS_PART2> Ep; Ep E{out, out, ws, 1.0f};
        pg8::gemm_phase<Ep, pg8::StaticOrder, PG8_ALIGN, PG8_SP2>(lds, g, S, E); }
    SEAM(7);
    if (IN(8)) { pg8::Gemm g{H, Wgu2, M, NGU, D}; pg8::StaticOrder S; S.init(M, NGU, G, bx); fill_rstd(lds, S, PART2, tid); EpiSwiGLU<true> E{ACT, FF, (const LAS float*)(lds + RS_OFF)};
        pg8::gemm_phase<EpiSwiGLU<true>, pg8::StaticOrder, PG8_ALIGN, PG8_SP2>(lds, g, S, E); }
    SEAM(8);
    if (IN(9)) { pg8::Gemm g{ACT, Wd2, M, D, FF}; pg8::StaticOrder S; S.init(M, D, G, bx); typedef EpiResid<false, 0, 0> Ep; Ep E{out, out, ws, 0.5f};
        pg8::gemm_phase<Ep, pg8::StaticOrder, PG8_ALIGN, PG8_SP2>(lds, g, S, E); }
    SEAM(9);
    if (IN(10)) { for (int m = gw; m < M; m += NGW) norm_row_f32(out + (size_t)m * D, fin_g, lane); }
#undef IN
#undef SEAM
}

#ifndef MK_N_LAUNCHES
#define MK_N_LAUNCHES 1
#endif
extern "C" void kernel_launch(void* const* d_in, const int* in_sizes, int n_in, void* d_out, int out_size, void* d_ws, size_t ws_size, hipStream_t stream) {
    static int grid = 0;
    if (grid == 0) {
        if (n_in != 17 || in_sizes[0] != M * D || out_size != M * D || ws_size < WS_END) { fprintf(stderr, "kernel_launch: unexpected shapes (n_in %d, in0 %d, out %d, ws %zu)\n", n_in, n_in > 0 ? in_sizes[0] : -1, out_size, ws_size); grid = -1; return; }
        int dev = 0, cus = 0, per_cu = 0;
        if (hipGetDevice(&dev) != hipSuccess || hipDeviceGetAttribute(&cus, hipDeviceAttributeMultiprocessorCount, dev) != hipSuccess) { grid = -1; return; }
        if (hipFuncSetAttribute((const void*)fwd_kernel, hipFuncAttributeMaxDynamicSharedMemorySize, LDS_BYTES) != hipSuccess) { fprintf(stderr, "kernel_launch: hipFuncSetAttribute failed\n"); grid = -1; return; }
        if (hipOccupancyMaxActiveBlocksPerMultiprocessor(&per_cu, (const void*)fwd_kernel, NTHR, LDS_BYTES) != hipSuccess || per_cu < 1) { fprintf(stderr, "kernel_launch: occupancy query says %d\n", per_cu); per_cu = 1; }
        (void)hipGetLastError();
        grid = cus * per_cu;
    }
    if (grid < 0) return;
    if (hipMemsetAsync((char*)d_ws + WS_CTL, 0, CTL_BYTES, stream) != hipSuccess) { fprintf(stderr, "kernel_launch: memset failed\n"); return; }
    Args a{};
    for (int i = 0; i < 17; ++i) a.in[i] = (const float*)d_in[i];
    a.out = (float*)d_out; a.ws = (unsigned char*)d_ws;
#if MK_N_LAUNCHES == 1
    a.ph_lo = 0; a.ph_hi = N_PHASES;
    void* args[] = {&a};
    hipError_t e = hipLaunchCooperativeKernel((const void*)fwd_kernel, dim3(grid), dim3(NTHR), args, LDS_BYTES, stream);
    if (e != hipSuccess) fprintf(stderr, "cooperative launch failed: %s (grid %d)\n", hipGetErrorString(e), grid);
#else
    for (int p = 0; p < N_PHASES; ++p) { a.ph_lo = p; a.ph_hi = p + 1; hipLaunchKernelGGL(fwd_kernel, dim3(grid), dim3(NTHR), LDS_BYTES, stream, a); }
#endif
}
```

```cpp
#include <hip/hip_runtime.h>
#include <cstdio>
#include <cstdint>
#include <hip/hip_cooperative_groups.h>
namespace pg8 {
#define PG8_LAS __attribute__((address_space(3)))
typedef unsigned short bf16_t;
typedef short bf16x8 __attribute__((ext_vector_type(8)));
typedef float f32x4 __attribute__((ext_vector_type(4)));
typedef unsigned u32x4 __attribute__((ext_vector_type(4)));
constexpr int BM = 256, BK = 64, HALF = 128, HTB = HALF * BK * 2  , STAGE_BYTES = 8 * HTB, NXCD = 8, WGM = 8;

__host__ __device__ __forceinline__ int lds_byte(int r, int c) { const int st = (r >> 4) * 2 + (c >> 5), rr = r & 15, cc = c & 31, ob = rr * 64 + cc * 2; return st * 1024 + (ob ^ (((ob >> 9) & 1) << 5)); }
__host__ __device__ __forceinline__ void stage_rc(int b, int& R, int& C) { const int st = b / 1024, sb = b % 1024, swz = sb ^ (((sb >> 9) & 1) << 5); R = (st >> 1) * 16 + swz / 64; C = (st & 1) * 32 + (swz % 64) / 2; }
__host__ __device__ __forceinline__ int perm32(int rho) { const int n = rho >> 4, i = rho & 15; return 8 * (i >> 2) + 4 * n + (i & 3); }

struct Unit { int pm, pn, ord; };
struct Gemm { const bf16_t* A; const bf16_t* Bt; int M, N, K; };

struct StaticOrder {
    int nM, nN, nwg, G, c;
    __host__ __device__ void init(int M, int N, int G_, int c_) { nM = M / BM; nN = N / BM; nwg = nM * nN; G = G_; c = c_; }
    __host__ __device__ bool next(int i, Unit& u) const {
        const long L = (long)i * G + c; if (L >= nwg) return false;
        int wgid = (int)L; { const int q = nwg / NXCD, r = nwg % NXCD, xcd = wgid % NXCD, off = wgid / NXCD; wgid = (xcd < r ? xcd * (q + 1) : r * (q + 1) + (xcd - r) * q) + off; }
        const int nig = WGM * nN, gid = wgid / nig, fm = gid * WGM, gsz = (nM - fm) < WGM ? (nM - fm) : WGM;
        u.pm = fm + ((wgid % nig) % gsz); u.pn = (wgid % nig) / gsz; u.ord = i; return true;
    }
    __device__ __forceinline__ void a_ready(const Unit&) const {}
    __device__ __forceinline__ void done(const Unit&) const {}
};

__device__ __forceinline__ unsigned cvt_pk_bf16(float lo, float hi) { unsigned r; asm volatile("v_cvt_pk_bf16_f32 %0, %1, %2" : "=v"(r) : "v"(lo), "v"(hi)); return r; }
typedef float f32x2 __attribute__((ext_vector_type(2)));
__device__ __forceinline__ f32x2 gelu_pk(f32x2 v) {
    const f32x2 av = __builtin_elementwise_abs(v), d = av * 0.2316418882f + 1.0f;
    f32x2 t; t.x = __builtin_amdgcn_rcpf(d.x); t.y = __builtin_amdgcn_rcpf(d.y);
    f32x2 q = t * 0.5307027145f + (-0.7265760135f); q = q * t + 0.7107068705f; q = q * t + (-0.142248368f); q = q * t + 0.127414796f; q = q * t;
    const f32x2 s = (v * v) * (-0.72134752044f);
    f32x2 e; e.x = __builtin_amdgcn_exp2f(s.x); e.y = __builtin_amdgcn_exp2f(s.y);
    const f32x2 m = v * (q * e), r = v - m;
    f32x2 o; o.x = v.x < 0.f ? m.x : r.x; o.y = v.y < 0.f ? m.y : r.y; return o;
}

template <int ACT  > struct EpiBf16 {
    static constexpr bool PERM = true, AFTER_DRAIN = false; static_assert(ACT == 0 || ACT == 1, "EpiBf16: ACT is 0 (none) or 1 (gelu_pk)");
    bf16_t* O; int ldc; const float* bias; int split_cols; size_t split_stride; float scale0;
    __device__ __forceinline__ void operator()(const f32x4 (&acc)[2][2][4][2], const Unit& u, int wr, int wc, int fr, int fq) const {
        const int row0 = u.pm * BM + wr * 64 + fr; int colt = u.pn * BM; bf16_t* base = O;
        float sc = 1.f; if (split_cols) { const int t = colt / split_cols; base += (size_t)t * split_stride; colt -= t * split_cols; if (t == 0) sc = scale0; }
        const int col0 = colt + wc * 32 + 8 * fq, bcol0 = u.pn * BM + wc * 32 + 8 * fq;
        f32x4 bv[2][2];
#pragma unroll
        for (int bj = 0; bj < 2; ++bj)
#pragma unroll
            for (int n = 0; n < 2; ++n) bv[bj][n] = bias ? *(const f32x4*)(bias + bcol0 + bj * HALF + 4 * n) : (f32x4){0.f, 0.f, 0.f, 0.f};
#pragma unroll
        for (int ai = 0; ai < 2; ++ai)
#pragma unroll
            for (int m = 0; m < 4; ++m) { bf16_t* rowp = base + (size_t)(row0 + ai * HALF + m * 16) * ldc + col0;
#pragma unroll
                for (int bj = 0; bj < 2; ++bj) { f32x4 v0 = acc[ai][bj][m][0] + bv[bj][0], v1 = acc[ai][bj][m][1] + bv[bj][1];
                    if (ACT == 1) { f32x2 a = gelu_pk((f32x2){v0[0], v0[1]}), b = gelu_pk((f32x2){v0[2], v0[3]}), c = gelu_pk((f32x2){v1[0], v1[1]}), d = gelu_pk((f32x2){v1[2], v1[3]});
                        v0 = (f32x4){a.x, a.y, b.x, b.y}; v1 = (f32x4){c.x, c.y, d.x, d.y}; }
                    v0 = v0 * sc; v1 = v1 * sc; u32x4 w; w.x = cvt_pk_bf16(v0[0], v0[1]); w.y = cvt_pk_bf16(v0[2], v0[3]); w.z = cvt_pk_bf16(v1[0], v1[1]); w.w = cvt_pk_bf16(v1[2], v1[3]);
                    *(u32x4*)(rowp + bj * HALF) = w; } }
    }
};
template <class Epi, class Sched, bool ALIGN_EPI = false, bool SP2 = false>
__device__ __forceinline__ void gemm_phase(PG8_LAS unsigned char* lds, const Gemm g, const Sched S, const Epi E) {
    const int tid = threadIdx.x, wid = __builtin_amdgcn_readfirstlane(tid >> 6), lane = tid & 63, wr = wid >> 2, wc = wid & 3, fr = lane & 15, fq = lane >> 4;
    const int K = g.K, nt = K / BK;
    unsigned voffA[2], voffB[2];
#pragma unroll
    for (int i = 0; i < 2; ++i) { int R, C; stage_rc(tid * 16 + i * 8192, R, C); const int Rb = Epi::PERM ? ((R & ~31) + perm32(R & 31)) : R;
        voffA[i] = (unsigned)(R * K + C) * 2u; voffB[i] = (unsigned)(Rb * K + C) * 2u; }
    const size_t kstep = (size_t)(BK * 2);
    const size_t hstep = (size_t)HALF * K * 2;
    const size_t tstep = 2 * hstep;
    const unsigned ldsw = (unsigned)wid * 1024u;
    const int aoff = lds_byte(wr * 64 + fr, fq * 8), boff = lds_byte(wc * 32 + fr, fq * 8);
#define PG8_SA(b, h) (((b) * 2 + (h)) * HTB)
#define PG8_SB(b, h) ((4 + (b) * 2 + (h)) * HTB)
#define PG8_STAGE(bufoff, gbase, voff) do { _Pragma("unroll") for (int _i = 0; _i < 2; ++_i) \
        __builtin_amdgcn_global_load_lds((const unsigned*)((const char*)(gbase) + (voff)[_i]), (PG8_LAS unsigned*)(lds + (bufoff) + ldsw + _i * 8192), 16, 0, 0); } while (0)
#define PG8_LDA(dst, b, h) do { _Pragma("unroll") for (int m = 0; m < 4; ++m) _Pragma("unroll") for (int k = 0; k < 2; ++k) dst[m][k] = *(const PG8_LAS bf16x8*)(lds + PG8_SA(b, h) + aoff + m * 2048 + k * 1024); } while (0)
#define PG8_LDB(dst, b, h) do { _Pragma("unroll") for (int n = 0; n < 2; ++n) _Pragma("unroll") for (int k = 0; k < 2; ++k) dst[n][k] = *(const PG8_LAS bf16x8*)(lds + PG8_SB(b, h) + boff + n * 2048 + k * 1024); } while (0)
#define PG8_MMA(ai, bj, At, Bt) do { __builtin_amdgcn_s_setprio(1); _Pragma("unroll") for (int m = 0; m < 4; ++m) _Pragma("unroll") for (int n = 0; n < 2; ++n) _Pragma("unroll") for (int k = 0; k < 2; ++k) \
        acc[ai][bj][m][n] = __builtin_amdgcn_mfma_f32_16x16x32_bf16(Bt[n][k], At[m][k], acc[ai][bj][m][n], 0, 0, 0); __builtin_amdgcn_s_setprio(0); } while (0)
#define PG8_WAIT_V(n) asm volatile("s_waitcnt vmcnt(" #n ")" ::: "memory")
#define PG8_WAIT_L(n) asm volatile("s_waitcnt lgkmcnt(" #n ")" ::: "memory")
#define PG8_BAR __builtin_amdgcn_s_barrier()
#define PG8_SCHED __builtin_amdgcn_sched_barrier(0)
    Unit cur, nxt; int ui = 0;
    if (!S.next(0, cur)) return;
    f32x4 acc[2][2][4][2];
#pragma unroll
    for (int a = 0; a < 2; ++a)
#pragma unroll
        for (int b = 0; b < 2; ++b)
#pragma unroll
            for (int m = 0; m < 4; ++m)
#pragma unroll
                for (int n = 0; n < 2; ++n) acc[a][b][m][n] = (f32x4){0.f, 0.f, 0.f, 0.f};
    bf16x8 At[4][2], B0[2][2], B1[2][2];
    const char* cA = (const char*)g.A + (size_t)cur.pm * tstep; const char* cB = (const char*)g.Bt + (size_t)cur.pn * tstep;
    S.a_ready(cur);
    if constexpr (SP2) {
        PG8_STAGE(PG8_SB(0, 0), cB, voffB); PG8_STAGE(PG8_SB(0, 1), cB + hstep, voffB); PG8_STAGE(PG8_SA(0, 0), cA, voffA); PG8_STAGE(PG8_SA(0, 1), cA + hstep, voffA);
        if (wr == 1) PG8_BAR;
        PG8_WAIT_V(2); PG8_BAR;
        PG8_STAGE(PG8_SB(1, 0), cB + kstep, voffB); PG8_STAGE(PG8_SA(1, 0), cA + kstep, voffA); PG8_STAGE(PG8_SB(1, 1), cB + hstep + kstep, voffB);
        PG8_WAIT_V(6); PG8_BAR;
    } else {
        PG8_STAGE(PG8_SB(0, 0), cB, voffB); PG8_STAGE(PG8_SA(0, 0), cA, voffA); PG8_STAGE(PG8_SB(0, 1), cB + hstep, voffB); PG8_STAGE(PG8_SA(0, 1), cA + hstep, voffA);
        if (wr == 1) PG8_BAR;
        PG8_WAIT_V(4); PG8_BAR;
        PG8_STAGE(PG8_SB(1, 0), cB + kstep, voffB); PG8_STAGE(PG8_SA(1, 0), cA + kstep, voffA); PG8_STAGE(PG8_SB(1, 1), cB + hstep + kstep, voffB);
        PG8_WAIT_V(6); PG8_BAR;
    }
    for (;;) {
        const bool has_next = S.next(ui + 1, nxt);
        const char* nA = has_next ? (const char*)g.A + (size_t)nxt.pm * tstep : cA; const char* nB = has_next ? (const char*)g.Bt + (size_t)nxt.pn * tstep : cB;
        for (int t = 0; t < nt; t += 2) {
            const bool last = (t == nt - 2);
            const char* a1 = cA + (size_t)(t + 1) * kstep;
            const char* a2 = last ? nA : cA + (size_t)(t + 2) * kstep; const char* b2 = last ? nB : cB + (size_t)(t + 2) * kstep;
            const char* a3 = a2 + kstep; const char* b3 = b2 + kstep;
            if (last && has_next) S.a_ready(nxt);
            if constexpr (SP2) {
            PG8_LDB(B0, 0, 0); PG8_LDB(B1, 0, 1); PG8_SCHED; PG8_LDA(At, 0, 0); PG8_STAGE(PG8_SA(1, 1), a1 + hstep, voffA);
            PG8_WAIT_V(8); PG8_WAIT_L(0); PG8_BAR; PG8_MMA(0, 0, At, B0); PG8_MMA(0, 1, At, B1); PG8_BAR; PG8_SCHED;
            PG8_LDA(At, 0, 1); PG8_STAGE(PG8_SB(0, 0), b2, voffB); PG8_STAGE(PG8_SB(0, 1), b2 + hstep, voffB); PG8_STAGE(PG8_SA(0, 0), a2, voffA);
            PG8_WAIT_V(8); PG8_WAIT_L(0); PG8_BAR; PG8_MMA(1, 0, At, B0); PG8_MMA(1, 1, At, B1); PG8_BAR; PG8_SCHED;
            PG8_LDB(B0, 1, 0); PG8_LDB(B1, 1, 1); PG8_SCHED; PG8_LDA(At, 1, 0); PG8_STAGE(PG8_SA(0, 1), a2 + hstep, voffA);
            PG8_WAIT_V(8); PG8_WAIT_L(0); PG8_BAR; PG8_MMA(0, 0, At, B0); PG8_MMA(0, 1, At, B1); PG8_BAR; PG8_SCHED;
            PG8_LDA(At, 1, 1); PG8_STAGE(PG8_SB(1, 0), b3, voffB); PG8_STAGE(PG8_SB(1, 1), b3 + hstep, voffB); PG8_STAGE(PG8_SA(1, 0), a3, voffA);
            PG8_WAIT_V(8); PG8_WAIT_L(0); PG8_BAR; PG8_MMA(1, 0, At, B0); PG8_MMA(1, 1, At, B1); PG8_BAR; PG8_SCHED;
            } else {
            PG8_LDB(B0, 0, 0); PG8_SCHED; PG8_LDA(At, 0, 0); PG8_STAGE(PG8_SA(1, 1), a1 + hstep, voffA);
            PG8_WAIT_L(8); PG8_BAR; PG8_WAIT_L(0); PG8_MMA(0, 0, At, B0); PG8_BAR; PG8_SCHED;
            PG8_LDB(B1, 0, 1); PG8_STAGE(PG8_SB(0, 0), b2, voffB);
            PG8_BAR; PG8_WAIT_L(0); PG8_MMA(0, 1, At, B1); PG8_BAR;
            PG8_LDA(At, 0, 1); PG8_STAGE(PG8_SA(0, 0), a2, voffA);
            PG8_BAR; PG8_WAIT_L(0); PG8_MMA(1, 0, At, B0); PG8_BAR; PG8_SCHED;
            PG8_STAGE(PG8_SB(0, 1), b2 + hstep, voffB);
            PG8_WAIT_V(6); PG8_BAR; PG8_MMA(1, 1, At, B1); PG8_BAR;
            PG8_LDB(B0, 1, 0); PG8_SCHED; PG8_LDA(At, 1, 0); PG8_STAGE(PG8_SA(0, 1), a2 + hstep, voffA);
            PG8_WAIT_L(8); PG8_BAR; PG8_WAIT_L(0); PG8_MMA(0, 0, At, B0); PG8_BAR; PG8_SCHED;
            PG8_LDB(B1, 1, 1); PG8_STAGE(PG8_SB(1, 0), b3, voffB);
            PG8_BAR; PG8_WAIT_L(0); PG8_MMA(0, 1, At, B1); PG8_BAR;
            PG8_LDA(At, 1, 1); PG8_STAGE(PG8_SA(1, 0), a3, voffA);
            PG8_BAR; PG8_WAIT_L(0); PG8_MMA(1, 0, At, B0); PG8_BAR; PG8_SCHED;
            PG8_STAGE(PG8_SB(1, 1), b3 + hstep, voffB);
            PG8_WAIT_V(6); PG8_BAR; PG8_MMA(1, 1, At, B1); PG8_BAR;
            }
        }
        if constexpr (ALIGN_EPI) { if (wr == 0) PG8_BAR; }
        if constexpr (!Epi::AFTER_DRAIN) { E(acc, cur, wr, wc, fr, fq); S.done(cur); }
        if (!has_next) break;
#pragma unroll
        for (int a = 0; a < 2; ++a)
#pragma unroll
            for (int b = 0; b < 2; ++b)
#pragma unroll
                for (int m = 0; m < 4; ++m)
#pragma unroll
                    for (int n = 0; n < 2; ++n) acc[a][b][m][n] = (f32x4){0.f, 0.f, 0.f, 0.f};
        cur = nxt; cA = nA; cB = nB; ++ui;
        if constexpr (ALIGN_EPI) { if (wr == 1) PG8_BAR; }
    }
    PG8_WAIT_V(0);
    if constexpr (!ALIGN_EPI) { if (wr == 0) PG8_BAR; }
    PG8_BAR;
    if constexpr (Epi::AFTER_DRAIN) { E.fused(acc, cur, wr, wc, fr, fq, lds, wid, lane); S.done(cur); }
#undef PG8_SA
#undef PG8_SB
#undef PG8_STAGE
#undef PG8_LDA
#undef PG8_LDB
#undef PG8_MMA
#undef PG8_WAIT_V
#undef PG8_WAIT_L
#undef PG8_BAR
#undef PG8_SCHED
}
}

#ifndef PG8_SP2
#define PG8_SP2 true
#endif
#ifndef PG8_ALIGN
#define PG8_ALIGN true
#endif
namespace cg = cooperative_groups;
#define GAS __attribute__((address_space(1)))
#define LAS __attribute__((address_space(3)))
typedef unsigned short bf16;
typedef unsigned v4u __attribute__((ext_vector_type(4)));
typedef unsigned v2u __attribute__((ext_vector_type(2)));
typedef float f32x4 __attribute__((ext_vector_type(4)));
typedef float f32x2v __attribute__((ext_vector_type(2)));
typedef short bf16x8 __attribute__((ext_vector_type(8)));

constexpr int NWAVES = 8, NTHR = 512;
constexpr int BATCH = 4, T = 4096, D = 1024, M = BATCH * T, FF = 2816, NGU = 2 * FF, INW = 3088, LDP = 3072, WINROWS = 3328, CH = 64, NCH = T / CH;
constexpr int NUNITS = BATCH * 8 * NCH;
constexpr float RMS_EPS = 1e-6f;
constexpr size_t MiB = 1u << 20;
constexpr size_t WS_WGU1 = 0, WS_WD1 = 11 * MiB, WS_WIN = 33 * MiB / 2, WS_WOUT = 23 * MiB, WS_WGU2 = 25 * MiB, WS_WD2 = 36 * MiB;
constexpr size_t WS_TAB = 42 * MiB, WS_DEC = 43 * MiB, WS_H = 46 * MiB, WS_ST = WS_H, WS_PROJ = 78 * MiB, WS_ACT = WS_PROJ, WS_KV = 182 * MiB, WS_O = WS_KV, WS_LOWF = 246 * MiB, WS_END = 247 * MiB;
static_assert(WS_WD1 + (size_t)D * FF * 2 <= WS_WIN && WS_WIN + (size_t)WINROWS * D * 2 <= WS_WOUT && WS_WD2 + (size_t)D * FF * 2 <= WS_TAB, "ws map");
static_assert(WS_PROJ + (size_t)M * LDP * 2 <= WS_KV && WS_KV + (size_t)NUNITS * 8192 * 4 <= WS_END, "ws map");
constexpr size_t WS_CTL = 87 * MiB / 2, CTL_BYTES = 16384, WS_PART1 = 44 * MiB, WS_PART2 = 45 * MiB;
constexpr int LDS_BYTES = 147456, MISC_OFF = 131072 + 64;
constexpr int PB = 144;
constexpr int L_QP = 0, L_QM = 9216, L_KP = 18432, L_KM = 27648, L_QE = 36864, L_VT = 46080, L_PS = 64512, L_BS = 73728, L_LOW = 90368, L_TOT = 94464, L_RED = 96512, L_KDT = 0;

__device__ __forceinline__ unsigned pk2(float lo, float hi) { return pg8::cvt_pk_bf16(lo, hi); }
__device__ __forceinline__ float bf2f(unsigned h) { return __builtin_bit_cast(float, h << 16); }
__device__ __forceinline__ float bflo(unsigned w) { return __builtin_bit_cast(float, w << 16); }
__device__ __forceinline__ float bfhi(unsigned w) { return __builtin_bit_cast(float, w & 0xffff0000u); }
__device__ __forceinline__ float wave_sum(float v) {
#pragma unroll
    for (int o = 1; o < 64; o <<= 1) v += __shfl_xor(v, o);
    return v;
}
__device__ __forceinline__ float silu_f(float g) { return g * __builtin_amdgcn_rcpf(1.0f + __expf(-g)); }

#define XB_TMO      128
#define XB_XCNT(j)  (256  + 64 * (j))
#define XB_XSUB(j)  (1280 + 64 * (j))
#define XB_XGEN(j)  (2304 + 64 * (j))
#define XB_TOP      3328
#define XB_TOPGEN   3392
#define XCD_BAR_WORDS 3456
#define XB_SPIN_CAP (1u << 18)

__device__ __forceinline__ unsigned xb_ld(unsigned* p)              { return __hip_atomic_load(p, __ATOMIC_RELAXED, __HIP_MEMORY_SCOPE_AGENT); }
__device__ __forceinline__ unsigned xb_add(unsigned* p, unsigned v) { return __hip_atomic_fetch_add(p, v, __ATOMIC_RELAXED, __HIP_MEMORY_SCOPE_AGENT); }
__device__ __forceinline__ unsigned xb_xcc_id() { return (unsigned)__builtin_amdgcn_s_getreg((3 << 11) | 20) & 0xFu; }
#define XB_SPIN(cond, bar) do { unsigned _sp = 0; while (cond) { __builtin_amdgcn_s_sleep(1); \
    if ((++_sp & 255u) == 0u) { if (xb_ld(&(bar)[XB_TMO])) break; if (_sp > XB_SPIN_CAP) { atomicAdd(&(bar)[XB_TMO], 1u); break; } } } } while (0)

struct XcdBarrier {
    unsigned* bar; unsigned x;
    volatile LAS unsigned* st;
};

__device__ __forceinline__ XcdBarrier xcd_barrier_post(unsigned* bar, volatile LAS unsigned* st) {
    XcdBarrier b; b.bar = bar; b.x = xb_xcc_id(); b.st = st;
    if (threadIdx.x == 0) (void)xb_add(&bar[XB_XCNT(b.x)], 1u);
    return b;
}
__device__ __forceinline__ void xcd_barrier_complete(unsigned* bar, unsigned x, unsigned& nloc, unsigned& nx) {
    const unsigned G = gridDim.x * gridDim.y * gridDim.z;
    unsigned sum, cnt, mine, sp = 0u;
    for (;;) {
        sum = 0u; cnt = 0u; mine = 0u;
#pragma unroll
        for (unsigned j = 0; j < 16; ++j) { const unsigned c = xb_ld(&bar[XB_XCNT(j)]); sum += c; cnt += (c > 0u) ? 1u : 0u; mine = (j == x) ? c : mine; }
        if (sum == G) break;
        __builtin_amdgcn_s_sleep(1);
        if ((++sp & 255u) == 0u) { if (xb_ld(&bar[XB_TMO])) break; if (sp > XB_SPIN_CAP) { atomicAdd(&bar[XB_TMO], 1u); break; } }
    }
    nloc = mine > 0u ? mine : 1u; nx = cnt > 0u ? cnt : 1u;
}

__device__ __forceinline__ void xcd_barrier(const XcdBarrier& b) {
    asm volatile("s_waitcnt vmcnt(0)" ::: "memory");
    __syncthreads();
    if (threadIdx.x == 0) {
        unsigned* bar = b.bar;
        __builtin_amdgcn_s_waitcnt(0);
        unsigned nloc = b.st[0], nx = b.st[1];
        if (nloc == 0u) { xcd_barrier_complete(bar, b.x, nloc, nx); b.st[0] = nloc; b.st[1] = nx; }
        const unsigned old = xb_add(&bar[XB_XSUB(b.x)], 1u);
        const unsigned gen = old / nloc;
        if (old + 1u == (gen + 1u) * nloc) {
            __builtin_amdgcn_fence(__ATOMIC_RELEASE, "agent");
            asm volatile("s_waitcnt vmcnt(0)" ::: "memory");
            const unsigned og = xb_add(&bar[XB_TOP], 1u);
            const unsigned tg = og / nx;
            if (og + 1u == (tg + 1u) * nx) xb_add(&bar[XB_TOPGEN], 1u);
            else XB_SPIN(xb_ld(&bar[XB_TOPGEN]) == tg, bar);
            __builtin_amdgcn_fence(__ATOMIC_ACQUIRE, "agent");
            xb_add(&bar[XB_XGEN(b.x)], 1u);
            asm volatile("s_waitcnt vmcnt(0)" ::: "memory");
        } else {
            XB_SPIN(xb_ld(&bar[XB_XGEN(b.x)]) == gen, bar);
            __builtin_amdgcn_fence(__ATOMIC_ACQUIRE, "agent");
            asm volatile("s_waitcnt vmcnt(0)" ::: "memory");
        }
    }
    __syncthreads();
}

__device__ __forceinline__ float row_rstd(const float* part, int row) {
    const pg8::f32x4* p = (const pg8::f32x4*)(part + (size_t)row * 16); const pg8::f32x4 a = p[0], b = p[1], c = p[2], d = p[3];
    const float s = ((a[0] + a[1]) + (a[2] + a[3])) + ((b[0] + b[1]) + (b[2] + b[3])) + ((c[0] + c[1]) + (c[2] + c[3])) + ((d[0] + d[1]) + (d[2] + d[3]));
    return 1.0f / sqrtf(s * (1.f / D) + RMS_EPS);
}
constexpr int RS_OFF = 131072 + 256, RS_UNITS = 14;
template <class Sched> __device__ __forceinline__ void fill_rstd(LAS unsigned char* lds, const Sched& S, const float* part, int tid) {
    LAS float* rs = (LAS float*)(lds + RS_OFF); pg8::Unit u;
    for (int i = 0; i < RS_UNITS && S.next(i, u); ++i) if (tid < 256) rs[i * 256 + tid] = row_rstd(part, u.pm * 256 + tid);
    __syncthreads();
}
template <bool SCALED> struct EpiSwiGLU {
    static constexpr bool PERM = true, AFTER_DRAIN = false;
    bf16* O; int ldc; const LAS float* rs;
    __device__ __forceinline__ void operator()(const pg8::f32x4 (&acc)[2][2][4][2], const pg8::Unit& u, int wr, int wc, int fr, int fq) const {
        const int row0 = u.pm * 256 + wr * 64 + fr, col0 = u.pn * 128 + wc * 32 + 8 * fq;
#pragma unroll
        for (int ai = 0; ai < 2; ++ai)
#pragma unroll
            for (int m = 0; m < 4; ++m) {
                const int row = row0 + ai * 128 + m * 16;
                const float r = SCALED ? rs[(u.ord < RS_UNITS ? u.ord : 0) * 256 + (row & 255)] : 1.0f;
                bf16* rowp = O + (size_t)row * ldc + col0;
                const pg8::f32x4 g0 = acc[ai][0][m][0] * r, g1 = acc[ai][0][m][1] * r, u0 = acc[ai][1][m][0] * r, u1 = acc[ai][1][m][1] * r;
                v4u w;
                w.x = pk2(silu_f(g0[0]) * u0[0], silu_f(g0[1]) * u0[1]); w.y = pk2(silu_f(g0[2]) * u0[2], silu_f(g0[3]) * u0[3]);
                w.z = pk2(silu_f(g1[0]) * u1[0], silu_f(g1[1]) * u1[1]); w.w = pk2(silu_f(g1[2]) * u1[2], silu_f(g1[3]) * u1[3]);
                *(v4u*)rowp = w;
            }
    }
};
struct EpiProj {
    static constexpr bool PERM = true, AFTER_DRAIN = false;
    bf16* O; int ldc; const LAS float* rs;
    __device__ __forceinline__ void operator()(const pg8::f32x4 (&acc)[2][2][4][2], const pg8::Unit& u, int wr, int wc, int fr, int fq) const {
        const int row0 = u.pm * 256 + wr * 64 + fr, col0 = u.pn * 256 + wc * 32 + 8 * fq;
#pragma unroll
        for (int ai = 0; ai < 2; ++ai)
#pragma unroll
            for (int m = 0; m < 4; ++m) {
                const int row = row0 + ai * 128 + m * 16;
                const float r = rs[(u.ord < RS_UNITS ? u.ord : 0) * 256 + (row & 255)];
                bf16* rowp = O + (size_t)row * ldc + col0;
#pragma unroll
                for (int bj = 0; bj < 2; ++bj) { const pg8::f32x4 v0 = acc[ai][bj][m][0] * r, v1 = acc[ai][bj][m][1] * r;
                    v4u w; w.x = pk2(v0[0], v0[1]); w.y = pk2(v0[2], v0[3]); w.z = pk2(v1[0], v1[1]); w.w = pk2(v1[2], v1[3]);
                    *(v4u*)(rowp + bj * 128) = w; }
            }
    }
};
template <bool STATS, size_t XB_OFF, size_t PART_OFF> struct EpiResid {
    static constexpr bool PERM = false, AFTER_DRAIN = false;
    const float* base; float* out; unsigned char* wsb; float scale;
    __device__ __forceinline__ void operator()(const pg8::f32x4 (&acc)[2][2][4][2], const pg8::Unit& u, int wr, int wc, int fr, int fq) const {
        constexpr int ldc = D;
        const int col0 = u.pn * 256 + wc * 32 + 4 * fq;
        unsigned char* w = wsb; asm volatile("" : "+s"(w));
        bf16* const xb = (bf16*)(w + XB_OFF); float* const part = (float*)(w + PART_OFF);
#pragma unroll
        for (int ai = 0; ai < 2; ++ai)
#pragma unroll
            for (int m = 0; m < 4; ++m) {
                const int row = u.pm * 256 + ai * 128 + wr * 64 + m * 16 + fr;
                const size_t off = (size_t)row * ldc + col0;
                float ss = 0.f;
#pragma unroll
                for (int bj = 0; bj < 2; ++bj)
#pragma unroll
                    for (int n = 0; n < 2; ++n) {
                        const pg8::f32x4 bs = *(const pg8::f32x4*)(base + off + bj * 128 + n * 16);
                        const pg8::f32x4 o = bs + acc[ai][bj][m][n] * scale;
                        *(pg8::f32x4*)(out + off + bj * 128 + n * 16) = o;
                        if (STATS) { *(v2u*)(xb + off + bj * 128 + n * 16) = (v2u){pk2(o[0], o[1]), pk2(o[2], o[3])}; ss += (o[0] * o[0] + o[1] * o[1]) + (o[2] * o[2] + o[3] * o[3]); }
                    }
                if (STATS) { ss += __shfl_xor(ss, 16); ss += __shfl_xor(ss, 32); if (fq == 0) part[(size_t)row * 16 + u.pn * 4 + wc] = ss; }
                asm volatile("" ::: "memory");
            }
    }
};

__device__ __forceinline__ void transpose_item(const float* W, int K, int N, bf16* WT, int nblk, int mode, LAS float* scr, int item, int lane, const float* gk = nullptr) {
    const int kb = item / nblk, nb = item % nblk, k0 = 64 * kb, n0 = 32 * nb;
    const int nn = n0 + (lane & 31); const bool ok = nn < N;
    float vals[32];
#pragma unroll
    for (int i = 0; i < 32; ++i) { const int kk = 2 * i + (lane >> 5); vals[i] = ok ? W[(size_t)(k0 + kk) * N + nn] : 0.f; }
    if (gk) {
#pragma unroll
        for (int i = 0; i < 32; ++i) vals[i] *= gk[k0 + 2 * i + (lane >> 5)];
    }
#pragma unroll
    for (int i = 0; i < 32; ++i) { const int kk = 2 * i + (lane >> 5); scr[kk * 33 + (lane & 31)] = vals[i]; }
    asm volatile("s_waitcnt lgkmcnt(0)" ::: "memory");
    const int c = lane & 7;
    const int drow0 = mode == 0 ? n0 : (256 * (n0 >> 7) + (n0 & 127) + (mode == 2 ? 128 : 0));
#pragma unroll
    for (int j = 0; j < 4; ++j) { const int n = (lane >> 3) + 8 * j; const LAS float* s = scr + (8 * c) * 33 + n;
        v4u o; o.x = pk2(s[0 * 33], s[1 * 33]); o.y = pk2(s[2 * 33], s[3 * 33]); o.z = pk2(s[4 * 33], s[5 * 33]); o.w = pk2(s[6 * 33], s[7 * 33]);
        *(v4u*)(WT + (size_t)(drow0 + n) * K + k0 + 8 * c) = o; }
    asm volatile("s_waitcnt lgkmcnt(0)" ::: "memory");
}
__device__ __forceinline__ void norm_row_bf16(const float* xrow, const float* g, bf16* orow, int lane) {
    const f32x4* xr = (const f32x4*)xrow + lane; const f32x4* gr = (const f32x4*)g + lane;
    f32x4 v[4]; float s = 0.f;
#pragma unroll
    for (int j = 0; j < 4; ++j) { v[j] = xr[64 * j]; s += (v[j].x * v[j].x + v[j].y * v[j].y) + (v[j].z * v[j].z + v[j].w * v[j].w); }
    const float r = 1.0f / sqrtf(wave_sum(s) * (1.f / D) + RMS_EPS);
    v2u* o8 = (v2u*)orow + lane;
#pragma unroll
    for (int j = 0; j < 4; ++j) { const f32x4 gg = gr[64 * j]; v2u o; o.x = pk2(v[j].x * r * gg.x, v[j].y * r * gg.y); o.y = pk2(v[j].z * r * gg.z, v[j].w * r * gg.w); o8[64 * j] = o; }
}
__device__ __forceinline__ void norm_row2_bf16(const float* xa, const float* xb_, const float* g, bf16* oa, bf16* ob, int lane) {
    const f32x4* ra = (const f32x4*)xa + lane; const f32x4* rb = (const f32x4*)xb_ + lane; const f32x4* gr = (const f32x4*)g + lane;
    f32x4 va[4], vb[4]; float sa = 0.f, sb = 0.f;
#pragma unroll
    for (int j = 0; j < 4; ++j) { va[j] = ra[64 * j]; vb[j] = rb[64 * j]; }
#pragma unroll
    for (int j = 0; j < 4; ++j) { sa += (va[j].x * va[j].x + va[j].y * va[j].y) + (va[j].z * va[j].z + va[j].w * va[j].w); sb += (vb[j].x * vb[j].x + vb[j].y * vb[j].y) + (vb[j].z * vb[j].z + vb[j].w * vb[j].w); }
    const float qa = 1.0f / sqrtf(wave_sum(sa) * (1.f / D) + RMS_EPS), qb = 1.0f / sqrtf(wave_sum(sb) * (1.f / D) + RMS_EPS);
    v2u* pa = (v2u*)oa + lane; v2u* pb = (v2u*)ob + lane;
#pragma unroll
    for (int j = 0; j < 4; ++j) { const f32x4 gg = gr[64 * j];
        v2u o; o.x = pk2(va[j].x * qa * gg.x, va[j].y * qa * gg.y); o.y = pk2(va[j].z * qa * gg.z, va[j].w * qa * gg.w); pa[64 * j] = o;
        v2u p; p.x = pk2(vb[j].x * qb * gg.x, vb[j].y * qb * gg.y); p.y = pk2(vb[j].z * qb * gg.z, vb[j].w * qb * gg.w); pb[64 * j] = p; }
}
__device__ __forceinline__ void norm_row_f32(float* xrow, const float* g, int lane) {
    f32x4* xr = (f32x4*)xrow + lane; const f32x4* gr = (const f32x4*)g + lane;
    f32x4 v[4]; float s = 0.f;
#pragma unroll
    for (int j = 0; j < 4; ++j) { v[j] = xr[64 * j]; s += (v[j].x * v[j].x + v[j].y * v[j].y) + (v[j].z * v[j].z + v[j].w * v[j].w); }
    const float r = 1.0f / sqrtf(wave_sum(s) * (1.f / D) + RMS_EPS);
#pragma unroll
    for (int j = 0; j < 4; ++j) { const f32x4 gg = gr[64 * j]; xr[64 * j] = (f32x4){v[j].x * r * gg.x, v[j].y * r * gg.y, v[j].z * r * gg.z, v[j].w * r * gg.w}; }
}

#define LBAR() do { asm volatile("s_waitcnt lgkmcnt(0)" ::: "memory"); __builtin_amdgcn_s_barrier(); asm volatile("" ::: "memory"); } while (0)
struct UnitInfo { int b, h8, n, h; bool gla; size_t m0; int qcol, kcol, vcol, gcol, ocol; };
__device__ __forceinline__ UnitInfo unit_info(int u) {
    UnitInfo I; I.n = u & 63; I.h8 = (u >> 6) & 7; I.b = u >> 9; I.gla = I.h8 >= 4; I.h = I.h8 & 3; I.m0 = (size_t)I.b * T + (size_t)I.n * CH;
    const int base = I.gla ? 1536 : 0;
    I.qcol = base + 64 * I.h; I.kcol = base + 256 + 64 * I.h; I.vcol = base + 512 + 128 * I.h; I.gcol = base + 1024 + 128 * I.h; I.ocol = (I.gla ? 512 : 0) + 128 * I.h;
    return I;
}
struct RawIn { f32x2v low; v2u q0, q1, k0, k1; f32x4 t0, t1; v4u v0, v1; f32x4 wa0, wa1, wa2, wa3; float ba; };
template <bool NEED_Q>
__device__ __forceinline__ void attn_load(RawIn& R, int u, const bf16* proj, const float* lowf, const float* tab, const float* w_a2, const float* b_a, int tid) {
    const UnitInfo I = unit_info(u);
    { const int j = tid >> 3, g = tid & 7; const bf16* rp = proj + (I.m0 + j) * LDP;
      R.low = *(const f32x2v*)(lowf + (I.m0 + j) * 16 + 2 * g);
      R.k0 = *(const v2u*)(rp + I.kcol + 4 * g); R.k1 = *(const v2u*)(rp + I.kcol + 32 + 4 * g);
      if (NEED_Q) { R.q0 = *(const v2u*)(rp + I.qcol + 4 * g); R.q1 = *(const v2u*)(rp + I.qcol + 32 + 4 * g); }
      const float* tp = tab + ((size_t)(I.n * CH + j) * 32 + 4 * g) * 2; R.t0 = ((const f32x4*)tp)[0]; R.t1 = ((const f32x4*)tp)[1]; }
    { const int c = tid & 15, j = tid >> 4; R.v0 = *(const v4u*)(proj + (I.m0 + j) * LDP + I.vcol + 8 * c); R.v1 = *(const v4u*)(proj + (I.m0 + j + 32) * LDP + I.vcol + 8 * c); }
    { const int k = tid & 63; const float* wp = w_a2 + 64 * I.h + k;
      R.wa0 = (f32x4){wp[0], wp[256], wp[512], wp[768]}; R.wa1 = (f32x4){wp[1024], wp[1280], wp[1536], wp[1792]};
      R.wa2 = (f32x4){wp[2048], wp[2304], wp[2560], wp[2816]}; R.wa3 = (f32x4){wp[3072], wp[3328], wp[3584], wp[3840]}; R.ba = b_a[64 * I.h + k]; }
}
__device__ __forceinline__ void attn_compute_b(LAS unsigned char* lds, const UnitInfo& I, const RawIn& R, int tid) {
    LAS float* BS = (LAS float*)(lds + L_BS); LAS float* LOW = (LAS float*)(lds + L_LOW); LAS float* TOT = (LAS float*)(lds + L_TOT);
    const int k = tid & 63, w = tid >> 6;
    if (I.gla) {
        { const int j = tid >> 3, r = (tid & 7) * 2; LOW[j * 16 + r] = R.low.x; LOW[j * 16 + r + 1] = R.low.y; }
        LBAR();
        float la[8]; float run = 0.f;
#pragma unroll
        for (int jj = 0; jj < 8; ++jj) {
            const LAS f32x4* lp = (const LAS f32x4*)(LOW + (8 * w + jj) * 16);
            const f32x4 l0 = lp[0], l1 = lp[1], l2 = lp[2], l3 = lp[3];
            float z = R.ba;
            z += l0.x * R.wa0.x + l0.y * R.wa0.y + l0.z * R.wa0.z + l0.w * R.wa0.w;
            z += l1.x * R.wa1.x + l1.y * R.wa1.y + l1.z * R.wa1.z + l1.w * R.wa1.w;
            z += l2.x * R.wa2.x + l2.y * R.wa2.y + l2.z * R.wa2.z + l2.w * R.wa2.w;
            z += l3.x * R.wa3.x + l3.y * R.wa3.y + l3.z * R.wa3.z + l3.w * R.wa3.w;
            const float ls = fminf(z, 0.f) - __logf(1.0f + __expf(-fabsf(z)));
            run += ls * 0.0625f; la[jj] = run;
        }
        TOT[w * 64 + k] = run;
        LBAR();
        float off = 0.f;
#pragma unroll
        for (int w2 = 0; w2 < 7; ++w2) off += (w2 < w) ? TOT[w2 * 64 + k] : 0.f;
#pragma unroll
        for (int jj = 0; jj < 8; ++jj) BS[(8 * w + jj) * 65 + k] = la[jj] + off;
    } else {
        const float lg = __logf(1.0f - exp2f(-5.0f - (float)I.h));
#pragma unroll
        for (int jj = 0; jj < 8; ++jj) BS[(8 * w + jj) * 65 + k] = (float)(8 * w + jj + 1) * lg;
    }
    LBAR();
}
__device__ __forceinline__ void unpack8(const v2u x, const v2u y, float (&lo)[4], float (&hi)[4]) {
    lo[0] = bflo(x.x); lo[1] = bfhi(x.x); lo[2] = bflo(x.y); lo[3] = bfhi(x.y);
    hi[0] = bflo(y.x); hi[1] = bfhi(y.x); hi[2] = bflo(y.y); hi[3] = bfhi(y.y);
}
__device__ __forceinline__ void rotary8(const f32x4 t0, const f32x4 t1, float (&lo)[4], float (&hi)[4]) {
    const float c[4] = {t0.x, t0.z, t1.x, t1.z}, s[4] = {t0.y, t0.w, t1.y, t1.w};
#pragma unroll
    for (int e = 0; e < 4; ++e) { const float a = lo[e], b = hi[e]; lo[e] = a * c[e] - b * s[e]; hi[e] = a * s[e] + b * c[e]; }
}
__device__ __forceinline__ int swz_off(int row, int col) { return row * PB + ((((col >> 3) ^ (row >> 3)) & 7) << 4) + (col & 7) * 2; }
__device__ __forceinline__ void stage_vt(LAS unsigned char* lds, const RawIn& R, int tid) {
    const int c = tid & 15;
#pragma unroll
    for (int p = 0; p < 2; ++p) {
        const int j = (tid >> 4) + 32 * p;
        const v4u x = p ? R.v1 : R.v0;
        const unsigned xs[4] = {x.x, x.y, x.z, x.w};
#pragma unroll
        for (int e = 0; e < 8; ++e) { const unsigned short val = (unsigned short)((xs[e >> 1] >> (16 * (e & 1))) & 0xffffu);
            *(LAS unsigned short*)(lds + L_VT + swz_off(8 * c + e, j)) = val; }
    }
}
__device__ __forceinline__ bf16x8 frag_plain(LAS unsigned char* base, int t16, int kk, int lane) { const int row = 16 * t16 + (lane & 15); return *(const LAS bf16x8*)(base + row * PB + (32 * kk + 8 * (lane >> 4)) * 2); }
__device__ __forceinline__ bf16x8 frag_swz(LAS unsigned char* base, int t16, int kk, int lane) { const int row = 16 * t16 + (lane & 15); const int jc = 4 * kk + (lane >> 4); return *(const LAS bf16x8*)(base + row * PB + (((jc ^ (row >> 3)) & 7) << 4)); }
#define MFMA16(X, Y, C) __builtin_amdgcn_mfma_f32_16x16x32_bf16((X), (Y), (C), 0, 0, 0)

__device__ __forceinline__ void attn_pass_a(LAS unsigned char* lds, int u, const RawIn& R, float* KV, float* DEC, int tid) {
    const UnitInfo I = unit_info(u); const int lane = tid & 63, w = tid >> 6;
    LAS float* BS = (LAS float*)(lds + L_BS);
    attn_compute_b(lds, I, R, tid);
    {
        const int j = tid >> 3, g = tid & 7;
        float klo[4], khi[4];
        unpack8(R.k0, R.k1, klo, khi);
        if (!I.gla) { rotary8(R.t0, R.t1, klo, khi);
#pragma unroll
            for (int e = 0; e < 4; ++e) { klo[e] *= 0.125f; khi[e] *= 0.125f; } }
#pragma unroll
        for (int e = 0; e < 4; ++e) {
            const int c0 = 4 * g + e, c1 = c0 + 32;
            const float d0 = __expf(BS[63 * 65 + c0] - BS[j * 65 + c0]), d1 = __expf(BS[63 * 65 + c1] - BS[j * 65 + c1]);
            *(LAS unsigned short*)(lds + L_KDT + swz_off(c0, j)) = (unsigned short)(pk2(klo[e] * d0, 0.f) & 0xffffu);
            *(LAS unsigned short*)(lds + L_KDT + swz_off(c1, j)) = (unsigned short)(pk2(khi[e] * d1, 0.f) & 0xffffu);
        }
        if (tid < 64) DEC[(size_t)u * 64 + tid] = __expf(BS[63 * 65 + tid]);
    }
    stage_vt(lds, R, tid);
    LBAR();
    {
        const int vt = w; float* KVu = KV + (size_t)u * 8192;
#pragma unroll
        for (int kt = 0; kt < 4; ++kt) {
            f32x4 acc = {0.f, 0.f, 0.f, 0.f};
#pragma unroll
            for (int kk = 0; kk < 2; ++kk) acc = MFMA16(frag_swz(lds + L_VT, vt, kk, lane), frag_swz(lds + L_KDT, kt, kk, lane), acc);
            const int v0 = 16 * vt + 4 * (lane >> 4), k = 16 * kt + (lane & 15);
#pragma unroll
            for (int e = 0; e < 4; ++e) KVu[(v0 + e) * 64 + k] = acc[e];
        }
    }
}
__device__ __forceinline__ void attn_pass_c(LAS unsigned char* lds, int u, const RawIn& R, const bf16* proj, const bf16* ST, const float* ng_ret, const float* ng_gla, bf16* O, int tid) {
    const UnitInfo I = unit_info(u); const int lane = tid & 63, w = tid >> 6;
    LAS float* BS = (LAS float*)(lds + L_BS); LAS float* RED = (LAS float*)(lds + L_RED);
    const int it_o = w & 3, vh = w >> 2, i_o = 16 * it_o + (lane & 15);
    bf16x8 stf[2][4]; v2u gv[4]; f32x4 g4[4];
    { const bf16* STu = ST + (size_t)u * 8192;
#pragma unroll
      for (int kk = 0; kk < 2; ++kk)
#pragma unroll
          for (int a = 0; a < 4; ++a) stf[kk][a] = *(const bf16x8*)(STu + (16 * (4 * vh + a) + (lane & 15)) * 64 + 32 * kk + 8 * (lane >> 4));
      const float* ng = (I.gla ? ng_gla : ng_ret) + 128 * I.h; const bf16* grow = proj + (I.m0 + i_o) * LDP + I.gcol;
#pragma unroll
      for (int a = 0; a < 4; ++a) { const int v0 = 16 * (4 * vh + a) + 4 * (lane >> 4); gv[a] = *(const v2u*)(grow + v0); g4[a] = *(const f32x4*)(ng + v0); } }
    attn_compute_b(lds, I, R, tid);
    {
        const int j = tid >> 3, g = tid & 7;
        float qlo[4], qhi[4], klo[4], khi[4];
        unpack8(R.q0, R.q1, qlo, qhi); unpack8(R.k0, R.k1, klo, khi);
        if (!I.gla) { rotary8(R.t0, R.t1, qlo, qhi); rotary8(R.t0, R.t1, klo, khi);
#pragma unroll
            for (int e = 0; e < 4; ++e) { klo[e] *= 0.125f; khi[e] *= 0.125f; } }
        else {
#pragma unroll
            for (int e = 0; e < 4; ++e) { qlo[e] *= 0.125f; qhi[e] *= 0.125f; } }
        float qp[8], qm[8], kp[8], km[8], qe[8];
#pragma unroll
        for (int e = 0; e < 4; ++e) {
            const int c0 = 4 * g + e, c1 = c0 + 32;
            const float b0 = BS[j * 65 + c0], b1 = BS[j * 65 + c1], r0 = BS[32 * 65 + c0], r1 = BS[32 * 65 + c1];
            const float p0 = __expf(b0 - r0), m0 = __expf(r0 - b0), p1 = __expf(b1 - r1), m1 = __expf(r1 - b1), e0 = __expf(b0), e1 = __expf(b1);
            qp[e] = qlo[e] * p0; qm[e] = qlo[e] * m0; kp[e] = klo[e] * p0; km[e] = klo[e] * m0; qe[e] = qlo[e] * e0;
            qp[4 + e] = qhi[e] * p1; qm[4 + e] = qhi[e] * m1; kp[4 + e] = khi[e] * p1; km[4 + e] = khi[e] * m1; qe[4 + e] = qhi[e] * e1;
        }
        const int o0 = j * PB + 8 * g, o1 = o0 + 64;
#define ST8(OFF, A) do { *(LAS v2u*)(lds + (OFF) + o0) = (v2u){pk2(A[0], A[1]), pk2(A[2], A[3])}; *(LAS v2u*)(lds + (OFF) + o1) = (v2u){pk2(A[4], A[5]), pk2(A[6], A[7])}; } while (0)
        ST8(L_QP, qp); ST8(L_QM, qm); ST8(L_KP, kp); ST8(L_KM, km); ST8(L_QE, qe);
#undef ST8
    }
    stage_vt(lds, R, tid);
    LBAR();
    {
        const int jt = w & 3;
#pragma unroll
        for (int ii = 0; ii < 2; ++ii) {
            const int it = (w >> 2) * 2 + ii;
            f32x4 lo = {0.f, 0.f, 0.f, 0.f}, hi = {0.f, 0.f, 0.f, 0.f};
#pragma unroll
            for (int kk = 0; kk < 2; ++kk) { lo = MFMA16(frag_plain(lds + L_KM, jt, kk, lane), frag_plain(lds + L_QP, it, kk, lane), lo);
                                             hi = MFMA16(frag_plain(lds + L_KP, jt, kk, lane), frag_plain(lds + L_QM, it, kk, lane), hi); }
            const int i = 16 * it + (lane & 15), j0 = 16 * jt + 4 * (lane >> 4);
            float s[4];
#pragma unroll
            for (int e = 0; e < 4; ++e) s[e] = (j0 + e <= i) ? lo[e] : hi[e];
            *(LAS v2u*)(lds + L_PS + i * PB + j0 * 2) = (v2u){pk2(s[0], s[1]), pk2(s[2], s[3])};
        }
    }
    LBAR();
    {
        f32x4 acc[4];
#pragma unroll
        for (int a = 0; a < 4; ++a) acc[a] = (f32x4){0.f, 0.f, 0.f, 0.f};
#pragma unroll
        for (int kk = 0; kk < 2; ++kk) {
            const bf16x8 y1 = frag_plain(lds + L_PS, it_o, kk, lane), y2 = frag_plain(lds + L_QE, it_o, kk, lane);
#pragma unroll
            for (int a = 0; a < 4; ++a) { const int vt = 4 * vh + a;
                acc[a] = MFMA16(frag_swz(lds + L_VT, vt, kk, lane), y1, acc[a]);
                acc[a] = MFMA16(stf[kk][a], y2, acc[a]); }
        }
        float ss = 0.f;
#pragma unroll
        for (int a = 0; a < 4; ++a) ss += (acc[a].x * acc[a].x + acc[a].y * acc[a].y) + (acc[a].z * acc[a].z + acc[a].w * acc[a].w);
        ss += __shfl_xor(ss, 16); ss += __shfl_xor(ss, 32);
        if ((lane >> 4) == 0) RED[i_o * 2 + vh] = ss;
        LBAR();
        const float r = 1.0f / sqrtf((RED[i_o * 2] + RED[i_o * 2 + 1]) * (1.f / 128.f) + RMS_EPS);
        bf16* orow = O + (I.m0 + i_o) * D + I.ocol;
#pragma unroll
        for (int a = 0; a < 4; ++a) { const int v0 = 16 * (4 * vh + a) + 4 * (lane >> 4);
            const float o0 = acc[a].x * r * g4[a].x * silu_f(bflo(gv[a].x)), o1 = acc[a].y * r * g4[a].y * silu_f(bfhi(gv[a].x)), o2 = acc[a].z * r * g4[a].z * silu_f(bflo(gv[a].y)), o3 = acc[a].w * r * g4[a].w * silu_f(bfhi(gv[a].y));
            *(v2u*)(orow + v0) = (v2u){pk2(o0, o1), pk2(o2, o3)}; }
    }
}
__device__ __forceinline__ void low_proj(LAS unsigned char* lds, const bf16* Hx, const bf16* WlowT, const float* part, float* lowf, int bx, int G, int tid) {
    const int lane = tid & 63, w = tid >> 6, rt = w & 3, kh = w >> 2;
    LAS float* red = (LAS float*)lds;
    for (int r0 = bx * 64; r0 < M; r0 += G * 64) {
        const bf16* hp = Hx + (size_t)(r0 + 16 * rt + (lane & 15)) * D + 512 * kh + 8 * (lane >> 4);
        const bf16* wp = WlowT + (size_t)(lane & 15) * D + 512 * kh + 8 * (lane >> 4);
        f32x4 acc = {0.f, 0.f, 0.f, 0.f};
#pragma unroll
        for (int q = 0; q < 16; ++q) acc = MFMA16(*(const bf16x8*)(wp + 32 * q), *(const bf16x8*)(hp + 32 * q), acc);
        if (kh == 1) *(LAS f32x4*)(red + (rt * 64 + lane) * 4) = acc;
        __syncthreads();
        if (kh == 0) { const f32x4 o = *(const LAS f32x4*)(red + (rt * 64 + lane) * 4); const int row = r0 + 16 * rt + (lane & 15); const float r = row_rstd(part, row);
            *(f32x4*)(lowf + (size_t)row * 16 + 4 * (lane >> 4)) = (acc + o) * r; }
        __syncthreads();
    }
}
struct Args { const float* in[17]; float* out; unsigned char* ws; int ph_lo, ph_hi; };
constexpr int N_PHASES = 11;
__global__ void __launch_bounds__(NTHR, 2) fwd_kernel(Args a) {
    extern __shared__ __attribute__((aligned(16))) unsigned char lds_raw[];
    LAS unsigned char* lds = (LAS unsigned char*)lds_raw;
    cg::grid_group grid = cg::this_grid();
    const int tid = threadIdx.x, lane = tid & 63, wave = __builtin_amdgcn_readfirstlane(tid >> 6);
    const int G = gridDim.x, bx = blockIdx.x;
    const int gw = bx * NWAVES + wave, NGW = G * NWAVES;
    const long gt = (long)bx * NTHR + tid, NGT = (long)G * NTHR;
    unsigned char* ws = a.ws;
    const float* x = a.in[0];
    const float *ffn1_g = a.in[1], *ffn1_wg = a.in[2], *ffn1_wu = a.in[3], *ffn1_wd = a.in[4], *mix_g = a.in[5], *w_in = a.in[6], *ret_ng = a.in[7], *w_a2 = a.in[8], *b_a = a.in[9],
                *gla_ng = a.in[10], *w_out = a.in[11], *ffn2_g = a.in[12], *ffn2_wg = a.in[13], *ffn2_wu = a.in[14], *ffn2_wd = a.in[15], *fin_g = a.in[16];
    float* out = a.out;
    bf16 *Wgu1 = (bf16*)(ws + WS_WGU1), *Wd1 = (bf16*)(ws + WS_WD1), *Win = (bf16*)(ws + WS_WIN), *Wout = (bf16*)(ws + WS_WOUT), *Wgu2 = (bf16*)(ws + WS_WGU2), *Wd2 = (bf16*)(ws + WS_WD2);
    float* TAB = (float*)(ws + WS_TAB); float* DEC = (float*)(ws + WS_DEC); bf16* H = (bf16*)(ws + WS_H); bf16* STb = (bf16*)(ws + WS_ST);
    bf16* PROJ = (bf16*)(ws + WS_PROJ); bf16* ACT = (bf16*)(ws + WS_ACT); float* KV = (float*)(ws + WS_KV); bf16* Ob = (bf16*)(ws + WS_O); float* LOWF = (float*)(ws + WS_LOWF); float* PART1 = (float*)(ws + WS_PART1); float* PART2 = (float*)(ws + WS_PART2);
    const int lo = a.ph_lo, hi = a.ph_hi;
    if (tid < 16) ((LAS unsigned*)(lds + 131072))[tid + 0] = 0u;
    if (tid < 32) ((LAS unsigned*)(lds + 131072))[tid + 16] = 0u;
    __syncthreads();
    XcdBarrier bar = xcd_barrier_post((unsigned*)(ws + WS_CTL), (volatile LAS unsigned*)(lds + MISC_OFF));
    if (hi > 1000) grid.sync();
#define IN(k) (lo <= (k) && (k) < hi)
#define SEAM(k) do { if (IN(k) && IN((k) + 1)) xcd_barrier(bar); } while (0)

    if (IN(0)) {
        LAS float* scr = (LAS float*)(lds + wave * 16384);
        constexpr int I_G = (D / 64) * (FF / 32), I_D = (FF / 64) * (D / 32), I_IN = (D / 64) * 97, I_O = (D / 64) * (D / 32);
        constexpr int NITEMS = 6 * I_G + I_IN + I_O;
        static_assert(I_G == I_D, "items");
        for (int it = gw; it < NITEMS; it += NGW) {
            int r = it;
            if (r < I_G) { transpose_item(ffn1_wg, D, FF, Wgu1, FF / 32, 1, scr, r, lane); continue; } r -= I_G;
            if (r < I_G) { transpose_item(ffn1_wu, D, FF, Wgu1, FF / 32, 2, scr, r, lane); continue; } r -= I_G;
            if (r < I_D) { transpose_item(ffn1_wd, FF, D, Wd1, D / 32, 0, scr, r, lane); continue; } r -= I_D;
            if (r < I_G) { transpose_item(ffn2_wg, D, FF, Wgu2, FF / 32, 1, scr, r, lane, ffn2_g); continue; } r -= I_G;
            if (r < I_G) { transpose_item(ffn2_wu, D, FF, Wgu2, FF / 32, 2, scr, r, lane, ffn2_g); continue; } r -= I_G;
            if (r < I_D) { transpose_item(ffn2_wd, FF, D, Wd2, D / 32, 0, scr, r, lane); continue; } r -= I_D;
            if (r < I_IN) { transpose_item(w_in, D, INW, Win, 97, 0, scr, r, lane, mix_g); continue; } r -= I_IN;
            transpose_item(w_out, D, D, Wout, D / 32, 0, scr, r, lane);
        }
        for (long i = gt; i < (long)T * 32; i += NGT) { const int pos = (int)(i >> 5), f = (int)(i & 31);
            const float inv = powf(10000.0f, -(float)f * (1.0f / 32.0f)); const float ang = (float)pos * inv;
            *(f32x2v*)(TAB + 2 * i) = (f32x2v){cosf(ang), sinf(ang)}; }
        for (int m = gw; m < M; m += 2 * NGW) norm_row2_bf16(x + (size_t)m * D, x + (size_t)(m + NGW < M ? m + NGW : m) * D, ffn1_g, H + (size_t)m * D, H + (size_t)(m + NGW < M ? m + NGW : m) * D, lane);
    }
    SEAM(0);
    if (IN(1)) { pg8::Gemm g{H, Wgu1, M, NGU, D}; pg8::StaticOrder S; S.init(M, NGU, G, bx); EpiSwiGLU<false> E{ACT, FF, nullptr};
        pg8::gemm_phase<EpiSwiGLU<false>, pg8::StaticOrder, PG8_ALIGN, PG8_SP2>(lds, g, S, E); }
    SEAM(1);
    if (IN(2)) { pg8::Gemm g{ACT, Wd1, M, D, FF}; pg8::StaticOrder S; S.init(M, D, G, bx); typedef EpiResid<true, WS_H, WS_PART1> Ep; Ep E{x, out, ws, 0.5f};
        pg8::gemm_phase<Ep, pg8::StaticOrder, PG8_ALIGN, PG8_SP2>(lds, g, S, E); }
    SEAM(2);
    if (IN(3)) { pg8::Gemm g{H, Win, M, LDP, D}; pg8::StaticOrder S; S.init(M, LDP, G, bx); fill_rstd(lds, S, PART1, tid); EpiProj E{PROJ, LDP, (const LAS float*)(lds + RS_OFF)};
        pg8::gemm_phase<EpiProj, pg8::StaticOrder, PG8_ALIGN, PG8_SP2>(lds, g, S, E);
        low_proj(lds, H, Win + (size_t)3072 * D, PART1, LOWF, bx, G, tid); }
    SEAM(3);
    if (IN(4) && bx < NUNITS) {
        RawIn cur; attn_load<false>(cur, bx, PROJ, LOWF, TAB, w_a2, b_a, tid);
        __builtin_amdgcn_s_waitcnt(0x0F70);
        for (int u = bx; u < NUNITS; u += G) { RawIn nxt; attn_load<false>(nxt, (u + G < NUNITS) ? u + G : u, PROJ, LOWF, TAB, w_a2, b_a, tid);
            attn_pass_a(lds, u, cur, KV, DEC, tid);
            __builtin_amdgcn_sched_barrier(0); __builtin_amdgcn_s_waitcnt(0x4F70); __builtin_amdgcn_sched_barrier(0); cur = nxt; }
    }
    SEAM(4);
    if (IN(5)) {
        for (long e2 = gt; e2 < (long)BATCH * 8 * 4096; e2 += NGT) {
            const int bh = (int)(e2 >> 12), el = (int)(e2 & 4095) * 2, k = el & 63;
            float r0 = 0.f, r1 = 0.f;
            for (int n0 = 0; n0 < NCH; n0 += 8) {
                f32x2v kv[8], dc[8];
#pragma unroll
                for (int q = 0; q < 8; ++q) { const size_t uu = (size_t)bh * 64 + n0 + q; kv[q] = *(const f32x2v*)(KV + uu * 8192 + el); dc[q] = *(const f32x2v*)(DEC + uu * 64 + k); }
#pragma unroll
                for (int q = 0; q < 8; ++q) { const size_t uu = (size_t)bh * 64 + n0 + q; *(unsigned*)(STb + uu * 8192 + el) = pk2(r0, r1); r0 = dc[q].x * r0 + kv[q].x; r1 = dc[q].y * r1 + kv[q].y; }
            }
        }
    }
    SEAM(5);
    if (IN(6) && bx < NUNITS) {
        RawIn cur; attn_load<true>(cur, bx, PROJ, LOWF, TAB, w_a2, b_a, tid);
        __builtin_amdgcn_s_waitcnt(0x0F70);
        for (int u = bx; u < NUNITS; u += G) { RawIn nxt; attn_load<true>(nxt, (u + G < NUNITS) ? u + G : u, PROJ, LOWF, TAB, w_a2, b_a, tid);
            attn_pass_c(lds, u, cur, PROJ, STb, ret_ng, gla_ng, Ob, tid);
            __builtin_amdgcn_sched_barrier(0); __builtin_amdgcn_s_waitcnt(0x0F74); __builtin_amdgcn_sched_barrier(0); cur = nxt; }
    }
    SEAM(6);
    if (IN(7)) { pg8::Gemm g{Ob, Wout, M, D, D}; pg8::StaticOrder S; S.init(M, D, G, bx); typedef EpiResid<true, WS_H, WS_PART2> Ep; Ep E{out, out, ws, 1.0f};
        pg8::gemm_phase<Ep, pg8::StaticOrder, PG8_ALIGN, PG8_SP2>(lds, g, S, E); }
    SEAM(7);
    if (IN(8)) { pg8::Gemm g{H, Wgu2, M, NGU, D}; pg8::StaticOrder S; S.init(M, NGU, G, bx); fill_rstd(lds, S, PART2, tid); EpiSwiGLU<true> E{ACT, FF, (const LAS float*)(lds + RS_OFF)};
        pg8::gemm_phase<EpiSwiGLU<true>, pg8::StaticOrder, PG8_ALIGN, PG8_SP2>(lds, g, S, E); }
    SEAM(8);
    if (IN(9)) { pg8::Gemm g{ACT, Wd2, M, D, FF}; pg8::StaticOrder S; S.init(M, D, G, bx); typedef EpiResid<false, 0, 0> Ep; Ep E{out, out, ws, 0.5f};
        pg8::gemm_phase<Ep, pg8::StaticOrder, PG8_ALIGN, PG8_SP2>(lds, g, S, E); }
    SEAM(9);
    if (IN(10)) { for (int m = gw; m < M; m += NGW) norm_row_f32(out + (size_t)m * D, fin_g, lane); }
#undef IN
#undef SEAM
}

#ifndef MK_N_LAUNCHES
#define MK_N_LAUNCHES 1
#endif
extern "C" void kernel_launch(void* const* d_in, const int* in_sizes, int n_in, void* d_out, int out_size, void* d_ws, size_t ws_size, hipStream_t stream) {
    static int grid = 0;
    if (grid == 0) {
        if (n_in != 17 || in_sizes[0] != M * D || out_size != M * D || ws_size < WS_END) { fprintf(stderr, "kernel_launch: unexpected shapes (n_in %d, in0 %d, out %d, ws %zu)\n", n_in, n_in > 0 ? in_sizes[0] : -1, out_size, ws_size); grid = -1; return; }
        int dev = 0, cus = 0, per_cu = 0;
        if (hipGetDevice(&dev) != hipSuccess || hipDeviceGetAttribute(&cus, hipDeviceAttributeMultiprocessorCount, dev) != hipSuccess) { grid = -1; return; }
        if (hipFuncSetAttribute((const void*)fwd_kernel, hipFuncAttributeMaxDynamicSharedMemorySize, LDS_BYTES) != hipSuccess) { fprintf(stderr, "kernel_launch: hipFuncSetAttribute failed\n"); grid = -1; return; }
        if (hipOccupancyMaxActiveBlocksPerMultiprocessor(&per_cu, (const void*)fwd_kernel, NTHR, LDS_BYTES) != hipSuccess || per_cu < 1) { fprintf(stderr, "kernel_launch: occupancy query says %d\n", per_cu); per_cu = 1; }
        (void)hipGetLastError();
        grid = cus * per_cu;
    }
    if (grid < 0) return;
    if (hipMemsetAsync((char*)d_ws + WS_CTL, 0, CTL_BYTES, stream) != hipSuccess) { fprintf(stderr, "kernel_launch: memset failed\n"); return; }
    Args a{};
    for (int i = 0; i < 17; ++i) a.in[i] = (const float*)d_in[i];
    a.out = (float*)d_out; a.ws = (unsigned char*)d_ws;
#if MK_N_LAUNCHES == 1
    a.ph_lo = 0; a.ph_hi = N_PHASES;
    void* args[] = {&a};
    hipError_t e = hipLaunchCooperativeKernel((const void*)fwd_kernel, dim3(grid), dim3(NTHR), args, LDS_BYTES, stream);
    if (e != hipSuccess) fprintf(stderr, "cooperative launch failed: %s (grid %d)\n", hipGetErrorString(e), grid);
#else
    for (int p = 0; p < N_PHASES; ++p) { a.ph_lo = p; a.ph_hi = p + 1; hipLaunchKernelGGL(fwd_kernel, dim3(grid), dim3(NTHR), LDS_BYTES, stream, a); }
#endif
}
```
